# Optimizing an MI355X kernel written in HIP

```python
import jax, jax.numpy as jnp
from jax import lax
import numpy as np

D_MODEL = 1024
BATCH = 2
SEQ = 8192
DEPTH = 1

CHUNK = 64
Q_BLOCK = 128
MIX_WIDTH = D_MODEL
FOX_HEAD_DIM = 64
FOX_WIDTH = MIX_WIDTH // 2
FOX_HEADS = FOX_WIDTH // FOX_HEAD_DIM
GLA_HEADS = 4
GLA_VAL_WIDTH = MIX_WIDTH - FOX_WIDTH
GLA_VAL_DIM = GLA_VAL_WIDTH // GLA_HEADS
GLA_KEY_WIDTH = GLA_VAL_WIDTH // 2
GLA_KEY_DIM = GLA_KEY_WIDTH // GLA_HEADS
GLA_GATE_RANK = 16
GLA_GATE_TAU = 16.0
N_EXPERTS = 32
TOP_K = 4
D_FF = D_MODEL
SWIGLU_LIMIT = 7.0
SWIGLU_ALPHA = 1.702
EPS = 1e-5

PROJ_SPLITS = (FOX_WIDTH, FOX_WIDTH, FOX_WIDTH, FOX_HEADS,
               GLA_KEY_WIDTH, GLA_KEY_WIDTH, GLA_VAL_WIDTH, GLA_GATE_RANK, GLA_VAL_WIDTH)
PROJ_WIDTH = sum(PROJ_SPLITS)

kernel_name = "hybrid_fox_gla_moe_block"


def rmsnorm(x, g):
    xf = x.astype(jnp.float32)
    y = xf * lax.rsqrt(jnp.mean(xf * xf, axis=-1, keepdims=True) + EPS)
    return (y * g.astype(jnp.float32)).astype(x.dtype)


def split_columns(p):
    idx, acc = [], 0
    for s in PROJ_SPLITS[:-1]:
        acc += s
        idx.append(acc)
    return jnp.split(p, idx, axis=-1)


def forgetting_attention(q, k, v, f_logit):
    B, S, H, Dh = q.shape
    n_blocks = S // Q_BLOCK
    cum = jnp.cumsum(jax.nn.log_sigmoid(f_logit.astype(jnp.float32)), axis=1)
    cum_h = cum.transpose(0, 2, 1)
    qb = q.reshape(B, n_blocks, Q_BLOCK, H, Dh).transpose(1, 0, 3, 2, 4)
    cq = cum_h.reshape(B, H, n_blocks, Q_BLOCK).transpose(2, 0, 1, 3)
    kh = k.transpose(0, 2, 1, 3)
    vh = v.transpose(0, 2, 1, 3)
    key_pos = jnp.arange(S)
    scale = Dh ** -0.5

    def block(args):
        qi, cqi, i = args
        s = jnp.einsum('bhqd,bhkd->bhqk', qi, kh, preferred_element_type=jnp.float32) * scale
        s = s + cqi[..., :, None] - cum_h[..., None, :]
        q_pos = i * Q_BLOCK + jnp.arange(Q_BLOCK)
        s = jnp.where(key_pos[None, :] <= q_pos[:, None], s, -jnp.inf)
        p = jax.nn.softmax(s, axis=-1)
        return jnp.einsum('bhqk,bhkd->bhqd', p.astype(vh.dtype), vh)

    out = lax.map(block, (qb, cq, jnp.arange(n_blocks)))
    return out.transpose(1, 0, 3, 2, 4).reshape(B, S, H * Dh)


def gla_chunk_causal(q, k, v, log_a):
    B, S, H, Dk = q.shape
    Dv = v.shape[-1]
    nc = S // CHUNK
    qc = q.astype(jnp.float32).reshape(B, nc, CHUNK, H, Dk) * (Dk ** -0.5)
    kc = k.astype(jnp.float32).reshape(B, nc, CHUNK, H, Dk)
    vc = v.astype(jnp.float32).reshape(B, nc, CHUNK, H, Dv)
    cum = jnp.cumsum(log_a.astype(jnp.float32).reshape(B, nc, CHUNK, H, Dk), axis=2)
    total = cum[:, :, -1]
    k_dec = kc * jnp.exp(total[:, :, None] - cum)
    upd = jnp.einsum('bcshk,bcshv->bchkv', k_dec, vc)
    decay = jnp.exp(total)

    def step(state, inp):
        d, u = inp
        state = d[..., None] * state + u
        return state, state

    init = jnp.zeros((B, H, Dk, Dv), jnp.float32)
    _, states = lax.scan(step, init, (decay.transpose(1, 0, 2, 3), upd.transpose(1, 0, 2, 3, 4)))
    states = states.transpose(1, 0, 2, 3, 4)
    o = jnp.einsum('bcthk,bchkv->bcthv', qc, states)
    return o.reshape(B, S, H, Dv)


def hybrid_mixer(n, w_in, fox_f_bias, gla_gate_up, gla_gate_bias, gla_norm_g, w_out):
    B, S, _ = n.shape
    proj = n @ w_in
    fq, fk, fv, ff, gq, gk, gv, g_low, g_out = split_columns(proj)
    fox = forgetting_attention(fq.reshape(B, S, FOX_HEADS, FOX_HEAD_DIM),
                               fk.reshape(B, S, FOX_HEADS, FOX_HEAD_DIM),
                               fv.reshape(B, S, FOX_HEADS, FOX_HEAD_DIM),
                               ff + fox_f_bias)
    log_a = jax.nn.log_sigmoid((g_low @ gla_gate_up + gla_gate_bias).astype(jnp.float32)) / GLA_GATE_TAU
    o = gla_chunk_causal(gq.reshape(B, S, GLA_HEADS, GLA_KEY_DIM),
                         gk.reshape(B, S, GLA_HEADS, GLA_KEY_DIM),
                         gv.reshape(B, S, GLA_HEADS, GLA_VAL_DIM),
                         log_a.reshape(B, S, GLA_HEADS, GLA_KEY_DIM))
    o = o * lax.rsqrt(jnp.mean(o * o, axis=-1, keepdims=True) + EPS) * gla_norm_g.astype(jnp.float32)
    gla = (o.reshape(B, S, GLA_VAL_WIDTH) * jax.nn.silu(g_out.astype(jnp.float32))).astype(n.dtype)
    return jnp.concatenate([fox, gla], axis=-1) @ w_out


def moe_ffn(n, router_w, router_b, exp_w_in, exp_b_in, exp_w_out, exp_b_out):
    B, S, D = n.shape
    t = n.reshape(-1, D)
    logits = (t @ router_w + router_b).astype(jnp.float32)
    top_v, top_i = lax.top_k(logits, TOP_K)
    gates = jax.nn.softmax(top_v, axis=-1)
    combine = jnp.sum(jax.nn.one_hot(top_i, N_EXPERTS, dtype=jnp.float32) * gates[..., None], axis=1)

    def expert(acc, p):
        wi, bi, wo, bo, c = p
        h = t @ wi + bi
        gate = jnp.minimum(h[:, :D_FF], SWIGLU_LIMIT)
        lin = jnp.clip(h[:, D_FF:], -SWIGLU_LIMIT, SWIGLU_LIMIT)
        y = ((lin + 1.0) * (gate * jax.nn.sigmoid(SWIGLU_ALPHA * gate))) @ wo + bo
        return acc + c[:, None] * y.astype(jnp.float32), None

    acc, _ = lax.scan(expert, jnp.zeros(t.shape, jnp.float32),
                      (exp_w_in, exp_b_in, exp_w_out, exp_b_out, combine.T))
    return acc.astype(n.dtype).reshape(B, S, D)


def setup_inputs(seed: int = 0) -> dict:
    key = jax.random.key(seed)
    ks = jax.random.split(key, 20)
    f32 = jnp.float32
    nrm = lambda k, shape, s: jax.random.normal(k, shape, f32) * s
    return {
        "x": jax.random.normal(ks[0], (BATCH, SEQ, D_MODEL), f32),
        "norm1_g": 1.0 + nrm(ks[1], (DEPTH, D_MODEL), 0.02),
        "w_in": nrm(ks[2], (DEPTH, D_MODEL, PROJ_WIDTH), D_MODEL ** -0.5),
        "fox_f_bias": jnp.linspace(1.0, 5.0, FOX_HEADS, dtype=f32)[None] + nrm(ks[3], (DEPTH, FOX_HEADS), 0.1),
        "gla_gate_up": nrm(ks[4], (DEPTH, GLA_GATE_RANK, GLA_KEY_WIDTH), GLA_GATE_RANK ** -0.5),
        "gla_gate_bias": nrm(ks[5], (DEPTH, GLA_KEY_WIDTH), 0.1),
        "gla_norm_g": 1.0 + nrm(ks[6], (DEPTH, GLA_VAL_DIM), 0.02),
        "w_out": nrm(ks[7], (DEPTH, MIX_WIDTH, D_MODEL), MIX_WIDTH ** -0.5),
        "norm2_g": 1.0 + nrm(ks[8], (DEPTH, D_MODEL), 0.02),
        "router_w": nrm(ks[9], (DEPTH, D_MODEL, N_EXPERTS), D_MODEL ** -0.5),
        "router_b": nrm(ks[10], (DEPTH, N_EXPERTS), 0.01),
        "exp_w_in": nrm(ks[11], (DEPTH, N_EXPERTS, D_MODEL, 2 * D_FF), D_MODEL ** -0.5),
        "exp_b_in": nrm(ks[12], (DEPTH, N_EXPERTS, 2 * D_FF), 0.02),
        "exp_w_out": nrm(ks[13], (DEPTH, N_EXPERTS, D_FF, D_MODEL), D_FF ** -0.5),
        "exp_b_out": nrm(ks[14], (DEPTH, N_EXPERTS, D_MODEL), 0.02),
        "final_g": 1.0 + nrm(ks[15], (D_MODEL,), 0.02),
    }


def reference(x, norm1_g, w_in, fox_f_bias, gla_gate_up, gla_gate_bias, gla_norm_g, w_out,
              norm2_g, router_w, router_b, exp_w_in, exp_b_in, exp_w_out, exp_b_out, final_g):
    h = x
    for l in range(DEPTH):
        n = rmsnorm(h, norm1_g[l])
        h = h + hybrid_mixer(n, w_in[l], fox_f_bias[l], gla_gate_up[l], gla_gate_bias[l],
                             gla_norm_g[l], w_out[l])
        n = rmsnorm(h, norm2_g[l])
        h = h + moe_ffn(n, router_w[l], router_b[l], exp_w_in[l], exp_b_in[l],
                        exp_w_out[l], exp_b_out[l])
    return rmsnorm(h, final_g)
```

```cpp
#include <hip/hip_runtime.h>
#include <hip/hip_bf16.h>
#include <cstdio>
#include <cstdint>
#include <cmath>
namespace slow {
constexpr int B_ = 2, S_ = 8192, T_ = B_ * S_, D_ = 1024;
constexpr int PROJ = 3096, C_FQ = 0, C_FK = 512, C_FV = 1024, C_FF = 1536, C_GQ = 1544, C_GK = 1800, C_GV = 2056, C_GLOW = 2568, C_GOUT = 2584;
constexpr int NE = 32, TOPK = 4, NPAIR = T_ * TOPK;

__device__ __forceinline__ float wsum(float v) {
#pragma unroll
    for (int o = 1; o < 64; o <<= 1) v += __shfl_xor(v, o);
    return v;
}
__device__ __forceinline__ float log_sigmoid_f(float x) { return fminf(x, 0.f) - log1pf(expf(-fabsf(x))); }

__global__ void __launch_bounds__(256) k_rmsnorm(const float* x, const float* g, float* out, int rows) {
    const int row = blockIdx.x * 4 + (threadIdx.x >> 6), lane = threadIdx.x & 63;
    if (row >= rows) return;
    const float4* xr = (const float4*)(x + (size_t)row * D_);
    float4 v[4]; float s = 0.f;
#pragma unroll
    for (int j = 0; j < 4; ++j) { v[j] = xr[lane + 64 * j]; s += v[j].x * v[j].x + v[j].y * v[j].y + v[j].z * v[j].z + v[j].w * v[j].w; }
    const float r = rsqrtf(wsum(s) * (1.f / D_) + 1e-5f);
    const float4* gr = (const float4*)g; float4* o = (float4*)(out + (size_t)row * D_);
#pragma unroll
    for (int j = 0; j < 4; ++j) { const float4 gg = gr[lane + 64 * j]; o[lane + 64 * j] = make_float4(v[j].x * r * gg.x, v[j].y * r * gg.y, v[j].z * r * gg.z, v[j].w * r * gg.w); }
}

struct SG { const float* A; const int* arow; const float* B; const float* bias; const float* R; float* C; const int* seg; long strideB; long strideBias;
            int lda, ldb, ldr, ldc, M, N, K, dual_off; };
template <bool DUAL> __global__ void __launch_bounds__(256) k_sgemm(SG p) {
    __shared__ float As[16][68]; __shared__ float Bs[16][64]; __shared__ float Bs2[DUAL ? 16 : 1][64];
    const int z = blockIdx.z; int r0 = 0, r1 = p.M;
    if (p.seg) { r0 = p.seg[z]; r1 = p.seg[z + 1]; }
    const int rb = r0 + blockIdx.y * 64; if (rb >= r1) return;
    const int cb = blockIdx.x * 64;
    const float* Bz = p.B + (size_t)z * p.strideB; const float* biasz = p.bias ? p.bias + (size_t)z * p.strideBias : nullptr;
    const int tid = threadIdx.x, tx = tid & 15, ty = tid >> 4;
    const int ar = rb + (tid >> 2); const bool aok = ar < r1; const int asrc = aok ? (p.arow ? p.arow[ar] : ar) : 0;
    const float* Ap = p.A + (size_t)asrc * p.lda + (tid & 3) * 4;
    const int bk = tid >> 4, bc = cb + (tid & 15) * 4;
    float acc[4][4] = {}, acc2[4][4] = {};
    for (int k0 = 0; k0 < p.K; k0 += 16) {
        float4 av = aok ? *(const float4*)(Ap + k0) : make_float4(0.f, 0.f, 0.f, 0.f);
        As[(tid & 3) * 4 + 0][tid >> 2] = av.x; As[(tid & 3) * 4 + 1][tid >> 2] = av.y; As[(tid & 3) * 4 + 2][tid >> 2] = av.z; As[(tid & 3) * 4 + 3][tid >> 2] = av.w;
        const float* Bp = Bz + (size_t)(k0 + bk) * p.ldb;
#pragma unroll
        for (int j = 0; j < 4; ++j) { const int c = bc + j; Bs[bk][(tid & 15) * 4 + j] = (c < p.N) ? Bp[c] : 0.f; if (DUAL) Bs2[bk][(tid & 15) * 4 + j] = Bp[c + p.dual_off]; }
        __syncthreads();
#pragma unroll
        for (int kk = 0; kk < 16; ++kk) {
            float a[4], b[4], b2[4];
#pragma unroll
            for (int i = 0; i < 4; ++i) a[i] = As[kk][ty * 4 + i];
#pragma unroll
            for (int j = 0; j < 4; ++j) { b[j] = Bs[kk][tx * 4 + j]; if (DUAL) b2[j] = Bs2[kk][tx * 4 + j]; }
#pragma unroll
            for (int i = 0; i < 4; ++i)
#pragma unroll
                for (int j = 0; j < 4; ++j) { acc[i][j] = fmaf(a[i], b[j], acc[i][j]); if (DUAL) acc2[i][j] = fmaf(a[i], b2[j], acc2[i][j]); }
        }
        __syncthreads();
    }
#pragma unroll
    for (int i = 0; i < 4; ++i) { const int r = rb + ty * 4 + i; if (r >= r1) continue;
#pragma unroll
        for (int j = 0; j < 4; ++j) { const int c = cb + tx * 4 + j; if (c >= p.N) continue;
            float v = acc[i][j] + (biasz ? biasz[c] : 0.f);
            if (DUAL) { const float lin = fminf(fmaxf(acc2[i][j] + biasz[c + p.dual_off], -7.f), 7.f); const float gt = fminf(v, 7.f); v = (lin + 1.f) * (gt / (1.f + expf(-1.702f * gt))); }
            if (p.R) v += p.R[(size_t)r * p.ldr + c];
            p.C[(size_t)r * p.ldc + c] = v; } }
}

__global__ void k_fcum(const float* proj, const float* fbias, float* F) {
    const int bh = threadIdx.x; if (bh >= B_ * 8) return; const int b = bh >> 3, h = bh & 7;
    double acc = 0.0; const float fb = fbias[h];
    for (int t = 0; t < S_; ++t) { acc += (double)log_sigmoid_f(proj[(size_t)(b * S_ + t) * PROJ + C_FF + h] + fb); F[(size_t)bh * S_ + t] = (float)acc; }
}
__global__ void __launch_bounds__(128) k_fox(const float* proj, const float* F, float* cat) {
    __shared__ float Ks[64][64]; __shared__ float Vs[64][64]; __shared__ float Fs[64];
    const int bh = blockIdx.y, b = bh >> 3, h = bh & 7, q0 = blockIdx.x * 128, t = q0 + threadIdx.x;
    float q[64], o[64];
    const float* qp = proj + (size_t)(b * S_ + t) * PROJ + C_FQ + h * 64;
#pragma unroll
    for (int d = 0; d < 64; ++d) { q[d] = qp[d] * 0.125f; o[d] = 0.f; }
    const float Ft = F[(size_t)bh * S_ + t];
    float m = -INFINITY, l = 0.f;
    const int ntile = (q0 + 128) / 64;
    for (int kt = 0; kt < ntile; ++kt) {
        __syncthreads();
        for (int i = threadIdx.x; i < 64 * 64; i += 128) { const int r = i >> 6, c = i & 63; const float* kp = proj + (size_t)(b * S_ + kt * 64 + r) * PROJ; Ks[r][c] = kp[C_FK + h * 64 + c]; Vs[r][c] = kp[C_FV + h * 64 + c]; }
        if (threadIdx.x < 64) Fs[threadIdx.x] = F[(size_t)bh * S_ + kt * 64 + threadIdx.x];
        __syncthreads();
        for (int s = 0; s < 64; ++s) {
            if (kt * 64 + s > t) break;
            float sc = 0.f;
#pragma unroll
            for (int d = 0; d < 64; ++d) sc = fmaf(q[d], Ks[s][d], sc);
            sc += Ft - Fs[s];
            if (sc > m) { const float f = expf(m - sc); l *= f;
#pragma unroll
                for (int d = 0; d < 64; ++d) o[d] *= f;
                m = sc; }
            const float pw = expf(sc - m); l += pw;
#pragma unroll
            for (int d = 0; d < 64; ++d) o[d] = fmaf(pw, Vs[s][d], o[d]);
        }
    }
    const float il = 1.f / l; float* op = cat + (size_t)(b * S_ + t) * D_ + h * 64;
#pragma unroll
    for (int d = 0; d < 64; ++d) op[d] = o[d] * il;
}
__global__ void __launch_bounds__(256) k_loga(const float* proj, const float* gup, const float* gb, float* loga) {
    const int t = blockIdx.x, j = threadIdx.x; const float* gl = proj + (size_t)t * PROJ + C_GLOW; float s = gb[j];
#pragma unroll
    for (int r = 0; r < 16; ++r) s = fmaf(gl[r], gup[r * 256 + j], s);
    loga[(size_t)t * 256 + j] = log_sigmoid_f(s) * (1.f / 16.f);
}
__global__ void __launch_bounds__(256) k_gla_upd(const float* proj, const float* loga, float* upd, float* decay) {
    __shared__ float kd[64][65]; __shared__ float vs[64][128];
    const int h = blockIdx.x & 3, c = (blockIdx.x >> 2) & 127, b = blockIdx.x >> 9, tid = threadIdx.x; const size_t row0 = (size_t)b * S_ + c * 64;
    for (int i = tid; i < 64 * 128; i += 256) { const int r = i >> 7, cc = i & 127; vs[r][cc] = proj[(row0 + r) * PROJ + C_GV + h * 128 + cc]; }
    if (tid < 64) { float cum = 0.f; float cl[64];
#pragma unroll
        for (int t = 0; t < 64; ++t) { cum += loga[(row0 + t) * 256 + h * 64 + tid]; cl[t] = cum; }
#pragma unroll
        for (int t = 0; t < 64; ++t) kd[t][tid] = proj[(row0 + t) * PROJ + C_GK + h * 64 + tid] * expf(cum - cl[t]);
        decay[((size_t)(b * 128 + c) * 4 + h) * 64 + tid] = expf(cum); }
    __syncthreads();
    float* up = upd + ((size_t)(b * 128 + c) * 4 + h) * 64 * 128;
    for (int i = tid; i < 64 * 128; i += 256) { const int dk = i >> 7, dv = i & 127; float s = 0.f;
#pragma unroll 8
        for (int t = 0; t < 64; ++t) s = fmaf(kd[t][dk], vs[t][dv], s);
        up[i] = s; }
}
__global__ void __launch_bounds__(256) k_gla_scan(float* upd, const float* decay) {
    const int id = blockIdx.x * 256 + threadIdx.x; const int dv = id & 127, dk = (id >> 7) & 63, h = (id >> 13) & 3, b = id >> 15;
    float st = 0.f;
    for (int c = 0; c < 128; ++c) { const size_t base = ((size_t)(b * 128 + c) * 4 + h); const float d = decay[base * 64 + dk]; float* u = upd + (base * 64 + dk) * 128 + dv; st = fmaf(d, st, *u); *u = st; }
}
__global__ void __launch_bounds__(256) k_gla_out(const float* proj, const float* states, const float* gng, float* cat) {
    __shared__ float st[64][128]; __shared__ float qs[64][65];
    const int h = blockIdx.x & 3, c = (blockIdx.x >> 2) & 127, b = blockIdx.x >> 9, tid = threadIdx.x; const size_t row0 = (size_t)b * S_ + c * 64;
    const float* sp = states + ((size_t)(b * 128 + c) * 4 + h) * 64 * 128;
    for (int i = tid; i < 64 * 128; i += 256) st[i >> 7][i & 127] = sp[i];
    for (int i = tid; i < 64 * 64; i += 256) qs[i >> 6][i & 63] = proj[(row0 + (i >> 6)) * PROJ + C_GQ + h * 64 + (i & 63)] * 0.125f;
    __syncthreads();
    const int t = tid >> 2, dv0 = (tid & 3) * 32; float o[32]; float ss = 0.f;
#pragma unroll
    for (int j = 0; j < 32; ++j) { float s = 0.f;
#pragma unroll 8
        for (int dk = 0; dk < 64; ++dk) s = fmaf(qs[t][dk], st[dk][dv0 + j], s);
        o[j] = s; ss += s * s; }
    ss += __shfl_xor(ss, 1); ss += __shfl_xor(ss, 2);
    const float r = rsqrtf(ss * (1.f / 128.f) + 1e-5f);
#pragma unroll
    for (int j = 0; j < 32; ++j) { const float go = proj[(row0 + t) * PROJ + C_GOUT + h * 128 + dv0 + j]; cat[(row0 + t) * D_ + 512 + h * 128 + dv0 + j] = o[j] * r * gng[dv0 + j] * (go / (1.f + expf(-go))); }
}
__global__ void __launch_bounds__(256) k_topk(const float* logits, int* eidx, float* gate, int* cnt) {
    const int t = blockIdx.x * 256 + threadIdx.x; if (t >= T_) return;
    float v[32];
#pragma unroll
    for (int e = 0; e < 32; ++e) v[e] = logits[(size_t)t * 32 + e];
    int sel[4]; float sv[4];
#pragma unroll
    for (int k = 0; k < 4; ++k) { int bi = 0; float bv = -INFINITY;
#pragma unroll
        for (int e = 0; e < 32; ++e) { bool taken = false;
#pragma unroll
            for (int kk = 0; kk < 4; ++kk) if (kk < k && sel[kk] == e) taken = true;
            if (!taken && v[e] > bv) { bv = v[e]; bi = e; } }
        sel[k] = bi; sv[k] = bv; }
    const float mx = sv[0]; float ex[4], sum = 0.f;
#pragma unroll
    for (int k = 0; k < 4; ++k) { ex[k] = expf(sv[k] - mx); sum += ex[k]; }
#pragma unroll
    for (int k = 0; k < 4; ++k) { eidx[t * 4 + k] = sel[k]; gate[t * 4 + k] = ex[k] / sum; atomicAdd(&cnt[sel[k]], 1); }
}
__global__ void k_offsets(const int* cnt, int* seg, int* cursor) { if (threadIdx.x == 0) { int a = 0; for (int e = 0; e < 32; ++e) { seg[e] = a; a += cnt[e]; cursor[e] = 0; } seg[32] = a; } }
__global__ void __launch_bounds__(256) k_assign(const int* eidx, const int* seg, int* cursor, int* tok_of, int* slot_of) {
    const int i = blockIdx.x * 256 + threadIdx.x; if (i >= NPAIR) return; const int e = eidx[i]; const int s = seg[e] + atomicAdd(&cursor[e], 1); tok_of[s] = i >> 2; slot_of[i] = s;
}
__global__ void __launch_bounds__(256) k_combine(const float* h, const float* Y, const int* slot_of, const float* gate, const float* fg, float* out) {
    const int row = blockIdx.x * 4 + (threadIdx.x >> 6), lane = threadIdx.x & 63;
    float4 v[4];
#pragma unroll
    for (int j = 0; j < 4; ++j) v[j] = ((const float4*)(h + (size_t)row * D_))[lane + 64 * j];
    for (int k = 0; k < 4; ++k) { const float g = gate[row * 4 + k]; const float4* y = (const float4*)(Y + (size_t)slot_of[row * 4 + k] * D_);
#pragma unroll
        for (int j = 0; j < 4; ++j) { const float4 yy = y[lane + 64 * j]; v[j].x = fmaf(g, yy.x, v[j].x); v[j].y = fmaf(g, yy.y, v[j].y); v[j].z = fmaf(g, yy.z, v[j].z); v[j].w = fmaf(g, yy.w, v[j].w); } }
    float s = 0.f;
#pragma unroll
    for (int j = 0; j < 4; ++j) s += v[j].x * v[j].x + v[j].y * v[j].y + v[j].z * v[j].z + v[j].w * v[j].w;
    const float r = rsqrtf(wsum(s) * (1.f / D_) + 1e-5f);
#pragma unroll
    for (int j = 0; j < 4; ++j) { const float4 gg = ((const float4*)fg)[lane + 64 * j]; ((float4*)(out + (size_t)row * D_))[lane + 64 * j] = make_float4(v[j].x * r * gg.x, v[j].y * r * gg.y, v[j].z * r * gg.z, v[j].w * r * gg.w); }
}
}
extern "C" void kernel_launch(void* const* d_in, const int* in_sizes, int n_in, void* d_out, int out_size, void* d_ws, size_t ws_size, hipStream_t stream) {
    using namespace slow;
    const float* x = (const float*)d_in[0]; const float* n1g = (const float*)d_in[1]; const float* w_in = (const float*)d_in[2]; const float* fbias = (const float*)d_in[3];
    const float* gup = (const float*)d_in[4]; const float* gb = (const float*)d_in[5]; const float* gng = (const float*)d_in[6]; const float* w_out = (const float*)d_in[7];
    const float* n2g = (const float*)d_in[8]; const float* rw = (const float*)d_in[9]; const float* rb = (const float*)d_in[10]; const float* ewi = (const float*)d_in[11];
    const float* ebi = (const float*)d_in[12]; const float* ewo = (const float*)d_in[13]; const float* ebo = (const float*)d_in[14]; const float* fg = (const float*)d_in[15];
    float* out = (float*)d_out; unsigned char* ws = (unsigned char*)d_ws;
    constexpr size_t MiB = 1u << 20;
    float* sn = (float*)(ws + 0);
    float* sproj = (float*)(ws + 64 * MiB);
    float* scat = (float*)(ws + 258 * MiB);
    float* sloga = (float*)(ws + 322 * MiB);
    float* supd = (float*)(ws + 338 * MiB);
    float* sY = (float*)(ws + 64 * MiB);
    float* sh = (float*)(ws + 370 * MiB);
    float* sact = (float*)(ws + 434 * MiB);
    unsigned char* sm = ws + 690 * MiB;
    float* sF = (float*)(sm); float* sdecay = (float*)(sm + 1 * MiB); float* slogits = (float*)(sm + 2 * MiB);
    int* eidx = (int*)(sm + 4 * MiB); float* gate = (float*)(sm + 5 * MiB); int* tok_of = (int*)(sm + 6 * MiB); int* slot_of = (int*)(sm + 7 * MiB);
    int* cnt = (int*)(sm + 8 * MiB); int* seg = cnt + 64; int* cursor = cnt + 128;
    if (ws_size < 700 * MiB) return;
    (void)hipMemsetAsync(cnt, 0, 1024, stream);
    k_rmsnorm<<<T_ / 4, 256, 0, stream>>>(x, n1g, sn, T_);
    { SG p{}; p.A = sn; p.lda = D_; p.B = w_in; p.ldb = PROJ; p.C = sproj; p.ldc = PROJ; p.M = T_; p.N = PROJ; p.K = D_;
      k_sgemm<false><<<dim3((PROJ + 63) / 64, T_ / 64, 1), 256, 0, stream>>>(p); }
    k_fcum<<<1, 64, 0, stream>>>(sproj, fbias, sF);
    k_fox<<<dim3(S_ / 128, 16), 128, 0, stream>>>(sproj, sF, scat);
    k_loga<<<T_, 256, 0, stream>>>(sproj, gup, gb, sloga);
    k_gla_upd<<<B_ * 128 * 4, 256, 0, stream>>>(sproj, sloga, supd, sdecay);
    k_gla_scan<<<B_ * 4 * 64 * 128 / 256, 256, 0, stream>>>(supd, sdecay);
    k_gla_out<<<B_ * 128 * 4, 256, 0, stream>>>(sproj, supd, gng, scat);
    { SG p{}; p.A = scat; p.lda = D_; p.B = w_out; p.ldb = D_; p.R = x; p.ldr = D_; p.C = sh; p.ldc = D_; p.M = T_; p.N = D_; p.K = D_;
      k_sgemm<false><<<dim3(D_ / 64, T_ / 64, 1), 256, 0, stream>>>(p); }
    k_rmsnorm<<<T_ / 4, 256, 0, stream>>>(sh, n2g, sn, T_);
    { SG p{}; p.A = sn; p.lda = D_; p.B = rw; p.ldb = 32; p.bias = rb; p.C = slogits; p.ldc = 32; p.M = T_; p.N = 32; p.K = D_;
      k_sgemm<false><<<dim3(1, T_ / 64, 1), 256, 0, stream>>>(p); }
    k_topk<<<T_ / 256, 256, 0, stream>>>(slogits, eidx, gate, cnt);
    k_offsets<<<1, 64, 0, stream>>>(cnt, seg, cursor);
    k_assign<<<NPAIR / 256, 256, 0, stream>>>(eidx, seg, cursor, tok_of, slot_of);
    { SG p{}; p.A = sn; p.lda = D_; p.arow = tok_of; p.B = ewi; p.ldb = 2048; p.strideB = (long)D_ * 2048; p.bias = ebi; p.strideBias = 2048; p.C = sact; p.ldc = D_; p.M = NPAIR; p.N = D_; p.K = D_; p.seg = seg; p.dual_off = 1024;
      k_sgemm<true><<<dim3(D_ / 64, T_ / 64, 32), 256, 0, stream>>>(p); }
    { SG p{}; p.A = sact; p.lda = D_; p.B = ewo; p.ldb = D_; p.strideB = (long)D_ * D_; p.bias = ebo; p.strideBias = D_; p.C = sY; p.ldc = D_; p.M = NPAIR; p.N = D_; p.K = D_; p.seg = seg;
      k_sgemm<false><<<dim3(D_ / 64, T_ / 64, 32), 256, 0, stream>>>(p); }
    k_combine<<<T_ / 4, 256, 0, stream>>>(sh, sY, slot_of, gate, fg, out);
}
```

```cpp
#include <hip/hip_runtime.h>
#include <hip/hip_bf16.h>
#include <cstdio>
#include <cstdint>
#include <cmath>

namespace pg8 {
#define PG8_LAS __attribute__((address_space(3)))
typedef unsigned short bf16_t;
typedef short bf16x8 __attribute__((ext_vector_type(8)));
typedef float f32x4 __attribute__((ext_vector_type(4)));
typedef unsigned u32x4 __attribute__((ext_vector_type(4)));
constexpr int BM = 256, BK = 64, HALF = 128, HTB = HALF * BK * 2  , STAGE_BYTES = 8 * HTB, NXCD = 8, WGM = 8;

__host__ __device__ __forceinline__ int lds_byte(int r, int c) { const int st = (r >> 4) * 2 + (c >> 5), rr = r & 15, cc = c & 31, ob = rr * 64 + cc * 2; return st * 1024 + (ob ^ (((ob >> 9) & 1) << 5)); }
__host__ __device__ __forceinline__ void stage_rc(int b, int& R, int& C) { const int st = b / 1024, sb = b % 1024, swz = sb ^ (((sb >> 9) & 1) << 5); R = (st >> 1) * 16 + swz / 64; C = (st & 1) * 32 + (swz % 64) / 2; }
__host__ __device__ __forceinline__ int perm32(int rho) { const int n = rho >> 4, i = rho & 15; return 8 * (i >> 2) + 4 * n + (i & 3); }

struct Unit { int pm, pn, e, orow; };
struct Gemm { const bf16_t* A; const bf16_t* Bt; int M, N, K; };

struct StaticOrder {
    int nM, nN, nwg, G, c;
    __host__ __device__ void init(int M, int N, int G_, int c_) { nM = M / BM; nN = N / BM; nwg = nM * nN; G = G_; c = c_; }
    __host__ __device__ bool next(int i, Unit& u) const {
        const long L = (long)i * G + c; if (L >= nwg) return false;
        int wgid = (int)L; { const int q = nwg / NXCD, r = nwg % NXCD, xcd = wgid % NXCD, off = wgid / NXCD; wgid = (xcd < r ? xcd * (q + 1) : r * (q + 1) + (xcd - r) * q) + off; }
        const int nig = WGM * nN, gid = wgid / nig, fm = gid * WGM, gsz = (nM - fm) < WGM ? (nM - fm) : WGM;
        u.pm = fm + ((wgid % nig) % gsz); u.pn = (wgid % nig) / gsz; u.e = 0; u.orow = u.pm * BM; return true;
    }
    __device__ __forceinline__ const char* a_base(const Gemm& g, const Unit& u) const { return (const char*)g.A + (size_t)u.pm * ((size_t)BM * g.K * 2); }
    __device__ __forceinline__ const char* b_base(const Gemm& g, const Unit& u) const { return (const char*)g.Bt + (size_t)u.pn * ((size_t)BM * g.K * 2); }
    __device__ __forceinline__ void voff_a(const Gemm& g, const Unit&, const int (&RA)[2], const int (&CA)[2], unsigned (&v)[2][2]) const {
#pragma unroll
        for (int h = 0; h < 2; ++h)
#pragma unroll
            for (int i = 0; i < 2; ++i) v[h][i] = (unsigned)((RA[i] + h * HALF) * g.K + CA[i]) * 2u; }
    __device__ __forceinline__ void a_ready(const Unit&) const {}
    __device__ __forceinline__ void done(const Unit&) const {}
};

template <bool GATHER_> struct MoeOrder {
    static constexpr bool GATHER = GATHER_;
    const PG8_LAS int* tab; const PG8_LAS int* toks; int nN, G, vcu, total;
    __device__ __forceinline__ void init(const PG8_LAS int* tab_, const PG8_LAS int* toks_, int nN_, int G_, int c_) {
        tab = tab_; toks = toks_; nN = nN_; G = G_; vcu = (G_ % 8 == 0) ? (c_ % 8) * (G_ / 8) + c_ / 8 : c_; total = tab_[32] * nN_; }
    __device__ __forceinline__ bool next(int i, Unit& u) const {
        const int L = i * G + vcu; if (L >= total) return false;
        const int gm = L / nN; u.pn = L % nN; int e = 0;
#pragma unroll 1
        for (int j = 1; j < 32; ++j) e += (tab[j] <= gm) ? 1 : 0;
        u.e = e; u.pm = gm - tab[e]; u.orow = tab[64 + e] + u.pm * BM; u.pm |= (i << 16);
        return true; }
    __device__ __forceinline__ const char* a_base(const Gemm& g, const Unit& u) const { return GATHER ? (const char*)g.A : (const char*)g.A + (size_t)u.orow * ((size_t)g.K * 2); }
    __device__ __forceinline__ const char* b_base(const Gemm& g, const Unit& u) const { return (const char*)g.Bt + ((size_t)u.e * g.N + (size_t)u.pn * BM) * ((size_t)g.K * 2); }
    __device__ __forceinline__ void voff_a(const Gemm& g, const Unit& u, const int (&RA)[2], const int (&CA)[2], unsigned (&v)[2][2]) const {
#pragma unroll
        for (int h = 0; h < 2; ++h)
#pragma unroll
            for (int i = 0; i < 2; ++i) { const int r = RA[i] + h * HALF; const int row = GATHER ? toks[(u.pm >> 16) * BM + r] : r; v[h][i] = (unsigned)(row * g.K + CA[i]) * 2u; } }
    __device__ __forceinline__ void a_ready(const Unit&) const {}
    __device__ __forceinline__ void done(const Unit&) const {}
};

__device__ __forceinline__ unsigned cvt_pk_bf16(float lo, float hi) { unsigned r; asm volatile("v_cvt_pk_bf16_f32 %0, %1, %2" : "=v"(r) : "v"(lo), "v"(hi)); return r; }

struct EpiRoute {
    static constexpr bool PERM = true, AFTER_DRAIN = false;
    bf16_t* O; int M; float qscale;
    __device__ __forceinline__ void operator()(const f32x4 (&acc)[2][2][4][2], const Unit& u, int wr, int wc, int fr, int fq) const {
        const int pn = u.pn; size_t off; int ld, colt; float sc = 1.f;
        if (pn < 6) { off = (size_t)(pn >> 1) * M * 512; ld = 512; colt = (pn & 1) * 256; if (pn < 2) sc = qscale; }
        else if (pn < 8) { off = (size_t)3 * M * 512 + (size_t)(pn - 6) * M * 256; ld = 256; colt = 0; if (pn == 6) sc = 0.125f; }
        else { off = (size_t)(4 + ((pn - 8) >> 1)) * M * 512; ld = 512; colt = (pn & 1) * 256; }
        bf16_t* base = O + off; const int row0 = u.orow + wr * 64 + fr, col0 = colt + wc * 32 + 8 * fq;
#pragma unroll
        for (int ai = 0; ai < 2; ++ai)
#pragma unroll
            for (int m = 0; m < 4; ++m) { bf16_t* rowp = base + (size_t)(row0 + ai * HALF + m * 16) * ld + col0;
#pragma unroll
                for (int bj = 0; bj < 2; ++bj) { const f32x4 v0 = acc[ai][bj][m][0] * sc, v1 = acc[ai][bj][m][1] * sc;
                    u32x4 w; w.x = cvt_pk_bf16(v0[0], v0[1]); w.y = cvt_pk_bf16(v0[2], v0[3]); w.z = cvt_pk_bf16(v1[0], v1[1]); w.w = cvt_pk_bf16(v1[2], v1[3]);
                    *(u32x4*)(rowp + bj * HALF) = w; } }
    }
};
struct EpiResF32 {
    static constexpr bool PERM = false, AFTER_DRAIN = false;
    const float* res; float* out; int ldc;
    __device__ __forceinline__ void operator()(const f32x4 (&acc)[2][2][4][2], const Unit& u, int wr, int wc, int fr, int fq) const {
        const int row0 = u.orow + wr * 64 + fr, col0 = u.pn * BM + wc * 32 + 4 * fq;
#pragma unroll
        for (int ai = 0; ai < 2; ++ai)
#pragma unroll
            for (int m = 0; m < 4; ++m) { const size_t off = (size_t)(row0 + ai * HALF + m * 16) * ldc + col0;
#pragma unroll
                for (int bj = 0; bj < 2; ++bj)
#pragma unroll
                    for (int n = 0; n < 2; ++n) { const f32x4 r = *(const f32x4*)(res + off + bj * HALF + n * 16); *(f32x4*)(out + off + bj * HALF + n * 16) = acc[ai][bj][m][n] + r; } }
    }
};
struct EpiSwiglu {
    static constexpr bool PERM = true, AFTER_DRAIN = false;
    bf16_t* O; int ldc; const float* bias;
    __device__ __forceinline__ void operator()(const f32x4 (&acc)[2][2][4][2], const Unit& u, int wr, int wc, int fr, int fq) const {
        const int row0 = u.orow + wr * 64 + fr, j0 = u.pn * HALF + wc * 32 + 8 * fq; const float* bg = bias + (size_t)u.e * 2048 + j0;
        f32x4 bgv[2], blv[2];
#pragma unroll
        for (int n = 0; n < 2; ++n) { bgv[n] = *(const f32x4*)(bg + 4 * n); blv[n] = *(const f32x4*)(bg + 1024 + 4 * n); }
#pragma unroll
        for (int ai = 0; ai < 2; ++ai)
#pragma unroll
            for (int m = 0; m < 4; ++m) { float a[8];
#pragma unroll
                for (int n = 0; n < 2; ++n) { const f32x4 gt = acc[ai][0][m][n] + bgv[n], ln = acc[ai][1][m][n] + blv[n];
#pragma unroll
                    for (int i = 0; i < 4; ++i) { const float g = fminf(gt[i], 7.f), l = fminf(fmaxf(ln[i], -7.f), 7.f);
                        a[4 * n + i] = (l + 1.f) * g * __builtin_amdgcn_rcpf(1.f + __builtin_amdgcn_exp2f(-1.702f * 1.4426950408889634f * g)); } }
                u32x4 w; w.x = cvt_pk_bf16(a[0], a[1]); w.y = cvt_pk_bf16(a[2], a[3]); w.z = cvt_pk_bf16(a[4], a[5]); w.w = cvt_pk_bf16(a[6], a[7]);
                *(u32x4*)(O + (size_t)(row0 + ai * HALF + m * 16) * ldc + j0) = w; }
    }
};
struct EpiBiasBf16 {
    static constexpr bool PERM = true, AFTER_DRAIN = false;
    bf16_t* O; int ldc; const float* bias;
    __device__ __forceinline__ void operator()(const f32x4 (&acc)[2][2][4][2], const Unit& u, int wr, int wc, int fr, int fq) const {
        const int row0 = u.orow + wr * 64 + fr, col0 = u.pn * BM + wc * 32 + 8 * fq; const float* bb = bias + (size_t)u.e * ldc + col0;
        f32x4 bv[2][2];
#pragma unroll
        for (int bj = 0; bj < 2; ++bj)
#pragma unroll
            for (int n = 0; n < 2; ++n) bv[bj][n] = *(const f32x4*)(bb + bj * HALF + 4 * n);
#pragma unroll
        for (int ai = 0; ai < 2; ++ai)
#pragma unroll
            for (int m = 0; m < 4; ++m) { bf16_t* rowp = O + (size_t)(row0 + ai * HALF + m * 16) * ldc + col0;
#pragma unroll
                for (int bj = 0; bj < 2; ++bj) { const f32x4 v0 = acc[ai][bj][m][0] + bv[bj][0], v1 = acc[ai][bj][m][1] + bv[bj][1];
                    u32x4 w; w.x = cvt_pk_bf16(v0[0], v0[1]); w.y = cvt_pk_bf16(v0[2], v0[3]); w.z = cvt_pk_bf16(v1[0], v1[1]); w.w = cvt_pk_bf16(v1[2], v1[3]);
                    *(u32x4*)(rowp + bj * HALF) = w; } }
    }
};

template <class Epi, class Sched, bool ALIGN_EPI = false, bool SP2 = true>
__device__ __forceinline__ void gemm_phase(PG8_LAS unsigned char* lds, const Gemm g, const Sched& S, const Epi& E) {
    const int tid = threadIdx.x, wid = __builtin_amdgcn_readfirstlane(tid >> 6), lane = tid & 63, wr = wid >> 2, wc = wid & 3, fr = lane & 15, fq = lane >> 4;
    const int K = g.K, nt = K / BK;
    unsigned voffB[2]; int RA[2], CA[2];
#pragma unroll
    for (int i = 0; i < 2; ++i) { int R, C; stage_rc(tid * 16 + i * 8192, R, C); const int Rb = Epi::PERM ? ((R & ~31) + perm32(R & 31)) : R;
        RA[i] = R; CA[i] = C; voffB[i] = (unsigned)(Rb * K + C) * 2u; }
    unsigned cvA[2][2], nvA[2][2];
    const size_t kstep = (size_t)(BK * 2);
    const size_t hstep = (size_t)HALF * K * 2;
    const size_t tstep = 2 * hstep;
    const unsigned ldsw = (unsigned)wid * 1024u;
    const int aoff = lds_byte(wr * 64 + fr, fq * 8), boff = lds_byte(wc * 32 + fr, fq * 8);
#define PG8_SA(b, h) (((b) * 2 + (h)) * HTB)
#define PG8_SB(b, h) ((4 + (b) * 2 + (h)) * HTB)
#define PG8_STAGE(bufoff, gbase, voff) do { _Pragma("unroll") for (int _i = 0; _i < 2; ++_i) \
        __builtin_amdgcn_global_load_lds((const unsigned*)((const char*)(gbase) + (voff)[_i]), (PG8_LAS unsigned*)(lds + (bufoff) + ldsw + _i * 8192), 16, 0, 0); } while (0)
#define PG8_LDA(dst, b, h) do { _Pragma("unroll") for (int m = 0; m < 4; ++m) _Pragma("unroll") for (int k = 0; k < 2; ++k) dst[m][k] = *(const PG8_LAS bf16x8*)(lds + PG8_SA(b, h) + aoff + m * 2048 + k * 1024); } while (0)
#define PG8_LDB(dst, b, h) do { _Pragma("unroll") for (int n = 0; n < 2; ++n) _Pragma("unroll") for (int k = 0; k < 2; ++k) dst[n][k] = *(const PG8_LAS bf16x8*)(lds + PG8_SB(b, h) + boff + n * 2048 + k * 1024); } while (0)
#define PG8_MMA(ai, bj, At, Bt) do { __builtin_amdgcn_s_setprio(1); _Pragma("unroll") for (int m = 0; m < 4; ++m) _Pragma("unroll") for (int n = 0; n < 2; ++n) _Pragma("unroll") for (int k = 0; k < 2; ++k) \
        acc[ai][bj][m][n] = __builtin_amdgcn_mfma_f32_16x16x32_bf16(Bt[n][k], At[m][k], acc[ai][bj][m][n], 0, 0, 0); __builtin_amdgcn_s_setprio(0); } while (0)
#define PG8_WAIT_V(n) asm volatile("s_waitcnt vmcnt(" #n ")" ::: "memory")
#define PG8_WAIT_L(n) asm volatile("s_waitcnt lgkmcnt(" #n ")" ::: "memory")
#define PG8_BAR __builtin_amdgcn_s_barrier()
#define PG8_SCHED __builtin_amdgcn_sched_barrier(0)
    Unit cur, nxt; int ui = 0;
    if (!S.next(0, cur)) return;
    f32x4 acc[2][2][4][2];
#pragma unroll
    for (int a = 0; a < 2; ++a)
#pragma unroll
        for (int b = 0; b < 2; ++b)
#pragma unroll
            for (int m = 0; m < 4; ++m)
#pragma unroll
                for (int n = 0; n < 2; ++n) acc[a][b][m][n] = (f32x4){0.f, 0.f, 0.f, 0.f};
    bf16x8 At[4][2], B0[2][2], B1[2][2];
    const char* cA = S.a_base(g, cur); const char* cB = S.b_base(g, cur);
    S.a_ready(cur);
    S.voff_a(g, cur, RA, CA, cvA);
    if constexpr (SP2) {
        PG8_STAGE(PG8_SB(0, 0), cB, voffB); PG8_STAGE(PG8_SB(0, 1), cB + hstep, voffB); PG8_STAGE(PG8_SA(0, 0), cA, cvA[0]); PG8_STAGE(PG8_SA(0, 1), cA, cvA[1]);
        if (wr == 1) PG8_BAR;
        PG8_WAIT_V(2); PG8_BAR;
        PG8_STAGE(PG8_SB(1, 0), cB + kstep, voffB); PG8_STAGE(PG8_SA(1, 0), cA + kstep, cvA[0]); PG8_STAGE(PG8_SB(1, 1), cB + hstep + kstep, voffB);
        PG8_WAIT_V(6); PG8_BAR;
    } else {
        PG8_STAGE(PG8_SB(0, 0), cB, voffB); PG8_STAGE(PG8_SA(0, 0), cA, cvA[0]); PG8_STAGE(PG8_SB(0, 1), cB + hstep, voffB); PG8_STAGE(PG8_SA(0, 1), cA, cvA[1]);
        if (wr == 1) PG8_BAR;
        PG8_WAIT_V(4); PG8_BAR;
        PG8_STAGE(PG8_SB(1, 0), cB + kstep, voffB); PG8_STAGE(PG8_SA(1, 0), cA + kstep, cvA[0]); PG8_STAGE(PG8_SB(1, 1), cB + hstep + kstep, voffB);
        PG8_WAIT_V(6); PG8_BAR;
    }
    for (;;) {
        const bool has_next = S.next(ui + 1, nxt);
        const char* nA = has_next ? S.a_base(g, nxt) : cA; const char* nB = has_next ? S.b_base(g, nxt) : cB;
        if (has_next) S.voff_a(g, nxt, RA, CA, nvA); else { nvA[0][0] = cvA[0][0]; nvA[0][1] = cvA[0][1]; nvA[1][0] = cvA[1][0]; nvA[1][1] = cvA[1][1]; }
        for (int t = 0; t < nt; t += 2) {
            const bool last = (t == nt - 2);
            const char* a1 = cA + (size_t)(t + 1) * kstep;
            const char* a2 = last ? nA : cA + (size_t)(t + 2) * kstep; const char* b2 = last ? nB : cB + (size_t)(t + 2) * kstep;
            const char* a3 = a2 + kstep; const char* b3 = b2 + kstep;
            unsigned xA0[2], xA1[2];
            xA0[0] = last ? nvA[0][0] : cvA[0][0]; xA0[1] = last ? nvA[0][1] : cvA[0][1]; xA1[0] = last ? nvA[1][0] : cvA[1][0]; xA1[1] = last ? nvA[1][1] : cvA[1][1];
            if (last && has_next) S.a_ready(nxt);
            if constexpr (SP2) {
            PG8_LDB(B0, 0, 0); PG8_LDB(B1, 0, 1); PG8_SCHED; PG8_LDA(At, 0, 0); PG8_STAGE(PG8_SA(1, 1), a1, cvA[1]);
            PG8_WAIT_V(8); PG8_WAIT_L(0); PG8_BAR; PG8_MMA(0, 0, At, B0); PG8_MMA(0, 1, At, B1); PG8_BAR; PG8_SCHED;
            PG8_LDA(At, 0, 1); PG8_STAGE(PG8_SB(0, 0), b2, voffB); PG8_STAGE(PG8_SB(0, 1), b2 + hstep, voffB); PG8_STAGE(PG8_SA(0, 0), a2, xA0);
            PG8_WAIT_V(8); PG8_WAIT_L(0); PG8_BAR; PG8_MMA(1, 0, At, B0); PG8_MMA(1, 1, At, B1); PG8_BAR; PG8_SCHED;
            PG8_LDB(B0, 1, 0); PG8_LDB(B1, 1, 1); PG8_SCHED; PG8_LDA(At, 1, 0); PG8_STAGE(PG8_SA(0, 1), a2, xA1);
            PG8_WAIT_V(8); PG8_WAIT_L(0); PG8_BAR; PG8_MMA(0, 0, At, B0); PG8_MMA(0, 1, At, B1); PG8_BAR; PG8_SCHED;
            PG8_LDA(At, 1, 1); PG8_STAGE(PG8_SB(1, 0), b3, voffB); PG8_STAGE(PG8_SB(1, 1), b3 + hstep, voffB); PG8_STAGE(PG8_SA(1, 0), a3, xA0);
            PG8_WAIT_V(8); PG8_WAIT_L(0); PG8_BAR; PG8_MMA(1, 0, At, B0); PG8_MMA(1, 1, At, B1); PG8_BAR; PG8_SCHED;
            } else {
            PG8_LDB(B0, 0, 0); PG8_SCHED; PG8_LDA(At, 0, 0); PG8_STAGE(PG8_SA(1, 1), a1, cvA[1]);
            PG8_WAIT_L(8); PG8_BAR; PG8_WAIT_L(0); PG8_MMA(0, 0, At, B0); PG8_BAR; PG8_SCHED;
            PG8_LDB(B1, 0, 1); PG8_STAGE(PG8_SB(0, 0), b2, voffB);
            PG8_BAR; PG8_WAIT_L(0); PG8_MMA(0, 1, At, B1); PG8_BAR;
            PG8_LDA(At, 0, 1); PG8_STAGE(PG8_SA(0, 0), a2, xA0);
            PG8_BAR; PG8_WAIT_L(0); PG8_MMA(1, 0, At, B0); PG8_BAR; PG8_SCHED;
            PG8_STAGE(PG8_SB(0, 1), b2 + hstep, voffB);
            PG8_WAIT_V(6); PG8_BAR; PG8_MMA(1, 1, At, B1); PG8_BAR;
            PG8_LDB(B0, 1, 0); PG8_SCHED; PG8_LDA(At, 1, 0); PG8_STAGE(PG8_SA(0, 1), a2, xA1);
            PG8_WAIT_L(8); PG8_BAR; PG8_WAIT_L(0); PG8_MMA(0, 0, At, B0); PG8_BAR; PG8_SCHED;
            PG8_LDB(B1, 1, 1); PG8_STAGE(PG8_SB(1, 0), b3, voffB);
            PG8_BAR; PG8_WAIT_L(0); PG8_MMA(0, 1, At, B1); PG8_BAR;
            PG8_LDA(At, 1, 1); PG8_STAGE(PG8_SA(1, 0), a3, xA0);
            PG8_BAR; PG8_WAIT_L(0); PG8_MMA(1, 0, At, B0); PG8_BAR; PG8_SCHED;
            PG8_STAGE(PG8_SB(1, 1), b3 + hstep, voffB);
            PG8_WAIT_V(6); PG8_BAR; PG8_MMA(1, 1, At, B1); PG8_BAR;
            }
        }
        if constexpr (ALIGN_EPI) { if (wr == 0) PG8_BAR; }
        if constexpr (!Epi::AFTER_DRAIN) { E(acc, cur, wr, wc, fr, fq); S.done(cur); }
        if (!has_next) break;
#pragma unroll
        for (int a = 0; a < 2; ++a)
#pragma unroll
            for (int b = 0; b < 2; ++b)
#pragma unroll
                for (int m = 0; m < 4; ++m)
#pragma unroll
                    for (int n = 0; n < 2; ++n) acc[a][b][m][n] = (f32x4){0.f, 0.f, 0.f, 0.f};
        cur = nxt; cA = nA; cB = nB; ++ui; cvA[0][0] = nvA[0][0]; cvA[0][1] = nvA[0][1]; cvA[1][0] = nvA[1][0]; cvA[1][1] = nvA[1][1];
        if constexpr (ALIGN_EPI) { if (wr == 1) PG8_BAR; }
    }
    PG8_WAIT_V(0);
    if constexpr (!ALIGN_EPI) { if (wr == 0) PG8_BAR; }
    PG8_BAR;
    if constexpr (Epi::AFTER_DRAIN) { E.fused(acc, cur, wr, wc, fr, fq, lds, wid, lane); S.done(cur); }
#undef PG8_SA
#undef PG8_SB
#undef PG8_STAGE
#undef PG8_LDA
#undef PG8_LDB
#undef PG8_MMA
#undef PG8_WAIT_V
#undef PG8_WAIT_L
#undef PG8_BAR
#undef PG8_SCHED
}
}

constexpr int NWAVES = 8;
constexpr int BATCH = 2, SEQ = 8192, D = 1024, M = BATCH * SEQ;
constexpr int PROJW = 3096, NPROJ = 3072;
constexpr int FH = 8, GH = 4, NE = 32, TOPK = 4, ECAP = M, NSLOT = M * TOPK + NE * 256;
constexpr float LOG2E = 1.4426950408889634f, C2 = 0.125f * 1.4426950408889634f, EPS = 1e-5f;
constexpr size_t MiB = 1u << 20;
constexpr size_t WS_CTL = 0, CTL_ZERO_BYTES = 1 * MiB;
constexpr size_t WS_TOKL = 2 * MiB;
constexpr size_t WS_PIDX = 4 * MiB, WS_EIDX = WS_PIDX + 256 * 1024, WS_GATE = WS_EIDX + 256 * 1024;
constexpr size_t WS_FLT = 5 * MiB, WS_F2 = WS_FLT + 512 * 1024;
constexpr size_t WS_GLOW = 6 * MiB;
constexpr size_t WS_DECAY = 7 * MiB;
constexpr size_t WS_WIN = 8 * MiB, WS_WOUT = 14 * MiB, WS_E1 = 16 * MiB, WS_E2 = 144 * MiB;
constexpr size_t WS_XN = 208 * MiB;
constexpr size_t WS_P1 = 240 * MiB;
constexpr size_t WS_UPD = 336 * MiB;
constexpr size_t WS_CAT = 368 * MiB;
constexpr size_t WS_H = 400 * MiB;
constexpr size_t WS_ACT = 464 * MiB, WS_Y = 608 * MiB, WS_END = 752 * MiB;
static_assert((size_t)NSLOT * D * 2 <= 144 * MiB, "slot buffers");
constexpr int CW_TMO = 0, CW_CODE = 1, CW_BAR = 4096, CW_ECNT = 8192;
constexpr int RING_OFF = 0, RING_BYTES = 131072, EXTRA_OFF = RING_BYTES, EXTRA_BYTES = 28672, LDSCTL_OFF = EXTRA_OFF + EXTRA_BYTES, MISC_OFF = LDSCTL_OFF + 320, LDS_BYTES = 163840;
static_assert(MISC_OFF + 128 <= LDS_BYTES, "LDS map");

#define GAS __attribute__((address_space(1)))
#define LAS __attribute__((address_space(3)))
typedef unsigned short bf16;
typedef unsigned v4u __attribute__((ext_vector_type(4)));
typedef float f32x4 __attribute__((ext_vector_type(4)));
typedef short bf16x8 __attribute__((ext_vector_type(8)));
typedef GAS unsigned gu32;
typedef GAS unsigned long long gu64;
#define RLX_AGENT __ATOMIC_RELAXED, __HIP_MEMORY_SCOPE_AGENT
#define LDS_WAIT() asm volatile("s_waitcnt lgkmcnt(0)" ::: "memory")
#define VM_WAIT() asm volatile("s_waitcnt vmcnt(0)" ::: "memory")
__device__ __forceinline__ unsigned long long rt() { return __builtin_amdgcn_s_memrealtime(); }
__device__ __forceinline__ unsigned f2bf(float f) { unsigned u = __builtin_bit_cast(unsigned, f); return (u + 0x7fffu + ((u >> 16) & 1u)) >> 16; }
__device__ __forceinline__ unsigned pk2(float lo, float hi) { return f2bf(lo) | (f2bf(hi) << 16); }

#define XB_TMO      128
#define XB_XCNT(j)  (256  + 64 * (j))
#define XB_XSUB(j)  (1280 + 64 * (j))
#define XB_XGEN(j)  (2304 + 64 * (j))
#define XB_TOP      3328
#define XB_TOPGEN   3392
#define XCD_BAR_WORDS 3456
#define XB_SPIN_CAP (1u << 18)

__device__ __forceinline__ unsigned xb_ld(unsigned* p)              { return __hip_atomic_load(p, __ATOMIC_RELAXED, __HIP_MEMORY_SCOPE_AGENT); }
__device__ __forceinline__ unsigned xb_add(unsigned* p, unsigned v) { return __hip_atomic_fetch_add(p, v, __ATOMIC_RELAXED, __HIP_MEMORY_SCOPE_AGENT); }
__device__ __forceinline__ unsigned xb_xcc_id() { return (unsigned)__builtin_amdgcn_s_getreg((3 << 11) | 20) & 0xFu; }
#define XB_SPIN(cond, bar) do { unsigned _sp = 0; while (cond) { __builtin_amdgcn_s_sleep(1); \
    if ((++_sp & 255u) == 0u) { if (xb_ld(&(bar)[XB_TMO])) break; if (_sp > XB_SPIN_CAP) { atomicAdd(&(bar)[XB_TMO], 1u); break; } } } } while (0)

struct XcdBarrier {
    unsigned* bar; unsigned x;
    volatile LAS unsigned* st;
};

__device__ __forceinline__ XcdBarrier xcd_barrier_post(unsigned* bar, volatile LAS unsigned* st) {
    XcdBarrier b; b.bar = bar; b.x = xb_xcc_id(); b.st = st;
    if (threadIdx.x == 0) (void)xb_add(&bar[XB_XCNT(b.x)], 1u);
    return b;
}
__device__ __forceinline__ void xcd_barrier_complete(unsigned* bar, unsigned x, unsigned& nloc, unsigned& nx) {
    const unsigned G = gridDim.x * gridDim.y * gridDim.z;
    unsigned sum, cnt, mine, sp = 0u;
    for (;;) {
        sum = 0u; cnt = 0u; mine = 0u;
#pragma unroll
        for (unsigned j = 0; j < 16; ++j) { const unsigned c = xb_ld(&bar[XB_XCNT(j)]); sum += c; cnt += (c > 0u) ? 1u : 0u; mine = (j == x) ? c : mine; }
        if (sum == G) break;
        __builtin_amdgcn_s_sleep(1);
        if ((++sp & 255u) == 0u) { if (xb_ld(&bar[XB_TMO])) break; if (sp > XB_SPIN_CAP) { atomicAdd(&bar[XB_TMO], 1u); break; } }
    }
    nloc = mine > 0u ? mine : 1u; nx = cnt > 0u ? cnt : 1u;
}

__device__ __forceinline__ void xcd_barrier(const XcdBarrier& b) {
    asm volatile("s_waitcnt vmcnt(0)" ::: "memory");
    __syncthreads();
    if (threadIdx.x == 0) {
        unsigned* bar = b.bar;
        __builtin_amdgcn_s_waitcnt(0);
        unsigned nloc = b.st[0], nx = b.st[1];
        if (nloc == 0u) { xcd_barrier_complete(bar, b.x, nloc, nx); b.st[0] = nloc; b.st[1] = nx; }
        const unsigned old = xb_add(&bar[XB_XSUB(b.x)], 1u);
        const unsigned gen = old / nloc;
        if (old + 1u == (gen + 1u) * nloc) {
            __builtin_amdgcn_fence(__ATOMIC_RELEASE, "agent");
            asm volatile("s_waitcnt vmcnt(0)" ::: "memory");
            const unsigned og = xb_add(&bar[XB_TOP], 1u);
            const unsigned tg = og / nx;
            if (og + 1u == (tg + 1u) * nx) xb_add(&bar[XB_TOPGEN], 1u);
            else XB_SPIN(xb_ld(&bar[XB_TOPGEN]) == tg, bar);
            __builtin_amdgcn_fence(__ATOMIC_ACQUIRE, "agent");
            xb_add(&bar[XB_XGEN(b.x)], 1u);
            asm volatile("s_waitcnt vmcnt(0)" ::: "memory");
        } else {
            XB_SPIN(xb_ld(&bar[XB_XGEN(b.x)]) == gen, bar);
            __builtin_amdgcn_fence(__ATOMIC_ACQUIRE, "agent");
            asm volatile("s_waitcnt vmcnt(0)" ::: "memory");
        }
    }
    __syncthreads();
}

struct Frame {
    LAS unsigned char* lds; volatile LAS unsigned* MISC; gu32* ctl;
    int tid, lane, wave, vcu, G;
    const float *x, *n1g, *w_in, *fbias, *gup, *gbias, *gng, *w_out, *n2g, *rw, *rb, *ewi, *ebi, *ewo, *ebo, *fg; float* out; unsigned char* ws;
};
__device__ __forceinline__ float wave_sum(float v) {
#pragma unroll
    for (int o = 1; o < 64; o <<= 1) v += __shfl_xor(v, o);
    return v;
}
__device__ __forceinline__ float log_sigmoid_f(float x) { return fminf(x, 0.f) - log1pf(__expf(-fabsf(x))); }
#define BFLY_STEP(n, m) { const bool up_ = (lane & (m)) != 0; _Pragma("unroll") for (int i_ = 0; i_ < (n) / 2; ++i_) { const float send_ = up_ ? v[i_] : v[i_ + (n) / 2]; const float recv_ = __shfl_xor(send_, (m)); \
        const float keep_ = up_ ? v[i_ + (n) / 2] : v[i_]; v[i_] = keep_ + recv_; } }
__device__ __forceinline__ float bfly32(float (&v)[32], int lane) { BFLY_STEP(32, 32) BFLY_STEP(16, 16) BFLY_STEP(8, 8) BFLY_STEP(4, 4) BFLY_STEP(2, 2) return v[0] + __shfl_xor(v[0], 1); }

__device__ __forceinline__ void p0_transpose_blk(const float* W, int ld, int k0, int c0, bf16* WT, int K, int r0, LAS float* scr, int lane) {
#pragma unroll 8
    for (int i = 0; i < 32; ++i) { const int kk = 2 * i + (lane >> 5); scr[kk * 33 + (lane & 31)] = W[(size_t)(k0 + kk) * ld + c0 + (lane & 31)]; }
    LDS_WAIT(); asm volatile("" ::: "memory");
    const int c = lane & 7;
#pragma unroll
    for (int j = 0; j < 4; ++j) { const int n = (lane >> 3) + 8 * j; const LAS float* s = scr + (8 * c) * 33 + n;
        v4u o; o.x = pk2(s[0 * 33], s[1 * 33]); o.y = pk2(s[2 * 33], s[3 * 33]); o.z = pk2(s[4 * 33], s[5 * 33]); o.w = pk2(s[6 * 33], s[7 * 33]);
        *(GAS v4u*)(WT + (size_t)(r0 + n) * K + k0 + 8 * c) = o; }
    LDS_WAIT(); asm volatile("" ::: "memory");
}
constexpr int W24_LD = 1032;
__device__ __forceinline__ void p0_row(Frame& F, int m, const LAS float* w24, const f32x4 (&gv)[4], bf16* XN, float* FLT, float* GLOW) {
    int lane = F.lane; asm volatile("" : "+v"(lane));
    const GAS f32x4* xr = (const GAS f32x4*)(F.x + (size_t)m * D) + lane;
    f32x4 v[4]; float s = 0.f;
#pragma unroll
    for (int j = 0; j < 4; ++j) { v[j] = xr[64 * j]; s += (v[j].x * v[j].x + v[j].y * v[j].y) + (v[j].z * v[j].z + v[j].w * v[j].w); }
    const float rstd = 1.f / sqrtf(wave_sum(s) * (1.f / D) + EPS);
    GAS unsigned long long* o8 = (GAS unsigned long long*)(XN + (size_t)m * D) + lane;
#pragma unroll
    for (int j = 0; j < 4; ++j) { v[j] = v[j] * rstd * gv[j]; o8[64 * j] = (unsigned long long)pk2(v[j].x, v[j].y) | ((unsigned long long)pk2(v[j].z, v[j].w) << 32); }
    float a[32];
#pragma unroll
    for (int c = 0; c < 24; ++c) { float t = 0.f;
#pragma unroll
        for (int j = 0; j < 4; ++j) { const f32x4 w = *(const LAS f32x4*)(w24 + c * W24_LD + 256 * j + 4 * lane); t += (v[j].x * w.x + v[j].y * w.y) + (v[j].z * w.z + v[j].w * w.w); }
        a[c] = t; if ((c & 3) == 3) asm volatile("" ::: "memory"); }
#pragma unroll
    for (int c = 24; c < 32; ++c) a[c] = 0.f;
    const float tot = bfly32(a, lane);
    const int idx = lane >> 1;
    if ((lane & 1) == 0) {
        if (idx < 8) FLT[(size_t)idx * M + m] = log_sigmoid_f(tot + F.fbias[idx]) * LOG2E;
        else if (idx < 24) GLOW[(size_t)m * 16 + (idx - 8)] = tot;
    }
}
__device__ __forceinline__ void p0_prologue(Frame& F) {
    const int gw = F.vcu * NWAVES + F.wave, NGW = F.G * NWAVES, tid = F.tid;
    bf16* XN = (bf16*)(F.ws + WS_XN); float* FLT = (float*)(F.ws + WS_FLT); float* GLOW = (float*)(F.ws + WS_GLOW);
    LAS float* w24 = (LAS float*)(F.lds + RING_OFF);
    for (int it = 0; it < 16; ++it) { const int i = tid + 512 * it, k = i >> 3, c = i & 7; w24[c * W24_LD + k] = F.w_in[(size_t)k * PROJW + 1536 + c]; }
    for (int it = 0; it < 32; ++it) { const int i = tid + 512 * it, k = i >> 4, c = i & 15; w24[(8 + c) * W24_LD + k] = F.w_in[(size_t)k * PROJW + 2568 + c]; }
    __syncthreads();
    { f32x4 gv[4]; int lane_ = F.lane; asm volatile("" : "+v"(lane_));
#pragma unroll
      for (int j = 0; j < 4; ++j) gv[j] = ((const GAS f32x4*)F.n1g)[lane_ + 64 * j];
      for (int m = gw; m < M; m += NGW) p0_row(F, m, w24, gv, XN, FLT, GLOW); }
    __syncthreads();
    LAS float* scr = (LAS float*)(F.lds + RING_OFF + F.wave * 16384);
    bf16* WIN = (bf16*)(F.ws + WS_WIN); bf16* WOUT = (bf16*)(F.ws + WS_WOUT); bf16* E1 = (bf16*)(F.ws + WS_E1); bf16* E2 = (bf16*)(F.ws + WS_E2);
    constexpr int I_IN = 16 * 96, I_OUT = 16 * 32, I_E1 = 16 * 64, I_E2 = 16 * 32, NITEMS = I_IN + I_OUT + NE * (I_E1 + I_E2);
    for (int it = gw; it < NITEMS; it += NGW) {
        int r = it;
        if (r < I_IN) { const int kb = r / 96, nb = r % 96, r0 = 32 * nb, c0 = r0 + (r0 < 1536 ? 0 : (r0 < 2560 ? 8 : 24)); p0_transpose_blk(F.w_in, PROJW, 64 * kb, c0, WIN, D, r0, scr, F.lane); continue; } r -= I_IN;
        if (r < I_OUT) { const int kb = r / 32, nb = r % 32; p0_transpose_blk(F.w_out, D, 64 * kb, 32 * nb, WOUT, D, 32 * nb, scr, F.lane); continue; } r -= I_OUT;
        if (r < NE * I_E1) { const int e = r / I_E1, q = r % I_E1, kb = q / 64, nb = q % 64, r0 = 32 * nb, within = r0 & 255, c0 = (within >> 7) * 1024 + (r0 >> 8) * 128 + (within & 127);
            p0_transpose_blk(F.ewi + (size_t)e * D * 2048, 2048, 64 * kb, c0, E1 + (size_t)e * 2048 * D, D, r0, scr, F.lane); continue; } r -= NE * I_E1;
        { const int e = r / I_E2, q = r % I_E2, kb = q / 32, nb = q % 32; p0_transpose_blk(F.ewo + (size_t)e * D * D, D, 64 * kb, 32 * nb, E2 + (size_t)e * D * D, D, 32 * nb, scr, F.lane); }
    }
}

#include <hip/hip_bf16.h>
#include <cmath>
namespace attn_body {
using bf16=__hip_bfloat16;
using bf16x8=__attribute__((ext_vector_type(8)))short;
using s16x4=__attribute__((ext_vector_type(4)))short;
using f32x16=__attribute__((ext_vector_type(16)))float;
using u32x4=__attribute__((ext_vector_type(4)))unsigned;
constexpr int BATCH=2,NHEAD=8,SEQ=8192,D=64,DM=NHEAD*D,OPITCH=1024;
constexpr int NW=8,QBLK=32,QB=QBLK*NW,KVBLK=64,NQB=SEQ/QB;
constexpr int ATTN_PITCH=DM, ATTN_UNIT_ROWS=QB;
__device__ __forceinline__ int crow(int r,int hi){return (r&3)+8*(r>>2)+4*hi;}
#define SBAR() __builtin_amdgcn_sched_barrier(0)
__device__ __forceinline__ void cmask(f32x16&p0,f32x16&p1,int jb,int qrel,int hi){
  const float NEG=-INFINITY; int kb=64*jb+4*hi;
  #pragma unroll
  for(int r=0;r<16;++r){int kv=kb+(r&3)+8*(r>>2); if(kv>qrel)p0[r]=NEG; if(kv+32>qrel)p1[r]=NEG;}
}

constexpr int NSLOT=3, SLOTB=8192;
constexpr int LDS_K=0, LDS_V=NSLOT*SLOTB, LDS_WS=2*NSLOT*SLOTB, LDS_OST=LDS_WS+NW*64*4, LDS_F=LDS_OST+NW*4096, LDS_BYTES=LDS_F+SEQ*4;
constexpr float C2=0.125f*1.4426950408889634f;
__device__ __forceinline__ void glds16(const void*gsrc,unsigned lds_dst){unsigned keep;
  asm volatile("s_mov_b32 %0, m0\n\ts_mov_b32 m0, %2\n\ts_nop 0\n\tglobal_load_lds_dwordx4 %1, off\n\ts_mov_b32 m0, %0":"=&s"(keep):"v"(gsrc),"s"(lds_dst):"memory");}
__device__ __forceinline__ float max3f(float a,float b,float c){float r;asm("v_max3_f32 %0, %1, %2, %3":"=v"(r):"v"(a),"v"(b),"v"(c));return r;}
__device__ __forceinline__ float max2f(float a,float b){float r;asm("v_max_f32_e32 %0, %1, %2":"=v"(r):"v"(a),"v"(b));return r;}
__device__ __forceinline__ float fadd_s(float a,float b){float r;asm("v_add_f32_e32 %0, %1, %2":"=v"(r):"v"(a),"v"(b));return r;}
__device__ __forceinline__ float fsub_s(float a,float b){float r;asm("v_sub_f32_e32 %0, %1, %2":"=v"(r):"v"(a),"v"(b));return r;}
typedef float f32x2_t __attribute__((ext_vector_type(2))); typedef __bf16 bf16x2_t __attribute__((ext_vector_type(2)));
__device__ __forceinline__ unsigned cvtpk_s(float lo,float hi){f32x2_t v={lo,hi};bf16x2_t b=__builtin_convertvector(v,bf16x2_t);return __builtin_bit_cast(unsigned,b);}
#define WAIT_BAR(N) asm volatile("s_waitcnt vmcnt(" #N ") lgkmcnt(0)\n\ts_barrier":::"memory")

__device__ __forceinline__ void qkt(f32x16&p0,f32x16&p1,const char*Kslot,const bf16x8*qr,int r32,int hi){
  const char*kb=Kslot+hi*1024+r32*16;
  #pragma unroll
  for(int d0=0;d0<4;++d0){
    const bf16x8 b0=*reinterpret_cast<const bf16x8*>(kb+d0*2048);
    const bf16x8 b1=*reinterpret_cast<const bf16x8*>(kb+d0*2048+512);
    p0=__builtin_amdgcn_mfma_f32_32x32x16_bf16(b0,qr[d0],p0,0,0,0);p1=__builtin_amdgcn_mfma_f32_32x32x16_bf16(b1,qr[d0],p1,0,0,0);}
}
typedef __attribute__((address_space(3))) const char* lds_cptr;
typedef short v4i16_t __attribute__((ext_vector_type(4)));
__device__ __forceinline__ void kload8(bf16x8*kf,lds_cptr kp){
  kf[0]=*(const __attribute__((address_space(3))) bf16x8*)(kp);      kf[1]=*(const __attribute__((address_space(3))) bf16x8*)(kp+512);
  kf[2]=*(const __attribute__((address_space(3))) bf16x8*)(kp+2048); kf[3]=*(const __attribute__((address_space(3))) bf16x8*)(kp+2560);
  kf[4]=*(const __attribute__((address_space(3))) bf16x8*)(kp+4096); kf[5]=*(const __attribute__((address_space(3))) bf16x8*)(kp+4608);
  kf[6]=*(const __attribute__((address_space(3))) bf16x8*)(kp+6144); kf[7]=*(const __attribute__((address_space(3))) bf16x8*)(kp+6656);
}
__device__ __forceinline__ void kload2(bf16x8*kf,lds_cptr kp,int j){ kf[2*j]=*(const __attribute__((address_space(3))) bf16x8*)(kp+j*2048); kf[2*j+1]=*(const __attribute__((address_space(3))) bf16x8*)(kp+j*2048+512); }
typedef float f32x4_t __attribute__((ext_vector_type(4)));
__device__ __forceinline__ void fkinit(f32x16&c0,f32x16&c1,lds_cptr fp,float qoff){
  #pragma unroll
  for(int g=0;g<4;++g){ const f32x4_t a=*(const __attribute__((address_space(3))) f32x4_t*)(fp+g*32); const f32x4_t b=*(const __attribute__((address_space(3))) f32x4_t*)(fp+128+g*32);
    #pragma unroll
    for(int i=0;i<4;++i){ c0[4*g+i]=qoff-a[i]; c1[4*g+i]=qoff-b[i]; } }
}
__device__ __forceinline__ s16x4 vtr(lds_cptr p){ return __builtin_bit_cast(s16x4,__builtin_amdgcn_ds_read_tr16_b64_v4i16((__attribute__((address_space(3))) v4i16_t*)p)); }
__device__ __forceinline__ float rowmax(const f32x16&p0,const f32x16&p1){
  float a=max3f(p0[0],p0[1],p1[0]),b=max3f(p0[2],p0[3],p1[1]);a=max3f(a,p1[2],p1[3]);
  #pragma unroll
  for(int r=4;r<16;r+=4){a=max3f(a,p0[r],p0[r+1]);b=max3f(b,p0[r+2],p0[r+3]);a=max3f(a,p1[r],p1[r+1]);b=max3f(b,p1[r+2],p1[r+3]);}
  const float m=max2f(a,b);
  auto rr=__builtin_amdgcn_permlane32_swap(__float_as_uint(m),__float_as_uint(m),false,false);
  return max2f(__uint_as_float(rr[0]),__uint_as_float(rr[1]));
}
__device__ __forceinline__ void pv(f32x16*o,int vb,bf16x8 pa0,bf16x8 pa1,bf16x8 pa2,bf16x8 pa3){
  #pragma unroll
  for(int d0=0;d0<2;++d0){s16x4 lo[4],hi[4];
    #pragma unroll
    for(int ks=0;ks<4;++ks){
      asm volatile("ds_read_b64_tr_b16 %0,%1 offset:%c2":"=&v"(lo[ks]):"v"(vb),"i"(d0*4096+ks*1024):"memory");
      asm volatile("ds_read_b64_tr_b16 %0,%1 offset:%c2":"=&v"(hi[ks]):"v"(vb),"i"(d0*4096+ks*1024+512):"memory");}
    asm volatile("s_waitcnt lgkmcnt(0)":::"memory");SBAR();
    #define PK(k) (bf16x8){lo[k][0],lo[k][1],lo[k][2],lo[k][3],hi[k][0],hi[k][1],hi[k][2],hi[k][3]}
    o[d0]=__builtin_amdgcn_mfma_f32_32x32x16_bf16(pa0,PK(0),o[d0],0,0,0);
    o[d0]=__builtin_amdgcn_mfma_f32_32x32x16_bf16(pa1,PK(1),o[d0],0,0,0);
    o[d0]=__builtin_amdgcn_mfma_f32_32x32x16_bf16(pa2,PK(2),o[d0],0,0,0);
    o[d0]=__builtin_amdgcn_mfma_f32_32x32x16_bf16(pa3,PK(3),o[d0],0,0,0);
    #undef PK
  }
}

#ifndef ATTN_STORE16
#define ATTN_STORE16(p,v) (*(u32x4*)(p)=(v))
#endif
template<int THRL> __device__ __forceinline__ void attn_unit(int b,int h,int qb,const bf16*Q,const bf16*__restrict__ K,const bf16*__restrict__ V,const float*__restrict__ F2,bf16*O,char*shm){
  const int tid=threadIdx.x,lane=tid&63,r32=lane&31,hi=lane>>5; const int wid=__builtin_amdgcn_readfirstlane(tid>>6);
  const long rowbase=(long)b*SEQ; const int q0=qb*QB;
  const bf16*Qw=Q+(rowbase+q0+wid*QBLK)*DM+h*D;
  const bf16*Kh=K+rowbase*DM+h*D,*Vh=V+rowbase*DM+h*D;
  const unsigned lds0=(unsigned)(uintptr_t)shm;
  float*wsf=(float*)(shm+LDS_WS)+wid*64;
  const bf16*ksrc=Kh+(long)lane*DM+wid*8;
  const bf16*vsrc=Vh+(long)(16*(wid&3)+(lane>>2))*DM+(wid>>2)*32+(lane&3)*8;
  const unsigned kdst=lds0+LDS_K+wid*1024, vdst=lds0+LDS_V+wid*1024;
  #define DMA_K(t,slot) glds16(ksrc+(long)(t)*KVBLK*DM,(unsigned)__builtin_amdgcn_readfirstlane(kdst+(slot)))
  #define DMA_V(t,slot) glds16(vsrc+(long)(t)*KVBLK*DM,(unsigned)__builtin_amdgcn_readfirstlane(vdst+(slot)))
  const int vb0=(int)(lds0+LDS_V)+((lane>>4)&1)*32+(lane&3)*8+(4*hi+((lane&15)>>2))*64;
  const char*Kbase=shm+LDS_K; bf16x8 kf[8];
  const lds_cptr shm3=(lds_cptr)shm; const lds_cptr kp0=shm3+LDS_K+hi*1024+r32*16; const lds_cptr vp0=shm3+LDS_V+((lane>>4)&1)*32+(lane&3)*8+(4*hi+((lane&15)>>2))*64;
  const int NT=(q0+QB)/KVBLK;
  const float*F2h=F2+(long)(b*NHEAD+h)*SEQ;
  for(int p_=wid;p_<=qb;p_+=NW) glds16(F2h+p_*256+lane*4,(unsigned)__builtin_amdgcn_readfirstlane(lds0+LDS_F+p_*1024));
  const lds_cptr fp0=shm3+LDS_F+hi*16;
  DMA_K(0,0);DMA_V(0,0);DMA_K(1,SLOTB);
  bf16x8 qr[4];
  #pragma unroll
  for(int d0=0;d0<4;++d0)qr[d0]=*reinterpret_cast<const bf16x8*>(&Qw[(long)r32*DM+d0*16+hi*8]);
  const float F2q=F2h[q0+wid*QBLK+r32]; float mhat=0.f,l_reg=0.f,qoff=F2q;f32x16 o[2];o[0]=f32x16{};o[1]=f32x16{};
  const int qrel=wid*QBLK+r32;
  #define CMASK(P0,P1,t) do{int jb_=(t)-(NT-4); if(jb_>=0)cmask(P0,P1,jb_,qrel,hi);}while(0)
  bool resc=false;
  #define START(P0,P1) do{ const float rm=rowmax(P0,P1); resc=false; \
    { const float dl=rm; mhat=fadd_s(mhat,dl); \
      _Pragma("unroll") for(int r=0;r<16;++r){P0[r]=fsub_s(P0[r],dl);P1[r]=fsub_s(P1[r],dl);} \
      qoff=F2q-mhat; } \
    _Pragma("unroll") for(int r=0;r<16;++r)P0[r]=__builtin_amdgcn_exp2f(P0[r]); }while(0)
  #define RESC() do{ if(resc){ asm volatile("s_waitcnt lgkmcnt(0)":::"memory"); \
      _Pragma("unroll") for(int d_=0;d_<2;++d_) _Pragma("unroll") for(int r=0;r<16;++r)o[d_][r]*=wsf[crow(r,hi)]; } }while(0)
  f32x16 pA0,pA1,pB0,pB1;
  int sl_prev=0,sl_cur=0,sl_next=SLOTB;
  #define ROT() do{sl_prev=sl_cur;sl_cur=sl_next;sl_next=(sl_next==(NSLOT-1)*SLOTB)?0:sl_next+SLOTB;}while(0)
  DMA_K(2,2*SLOTB);
  WAIT_BAR(3);
  fkinit(pA0,pA1,fp0,qoff); qkt(pA0,pA1,Kbase,qr,r32,hi);asm volatile("s_nop 15\n\ts_nop 7":"+v"(pA0),"+v"(pA1));CMASK(pA0,pA1,0);
  START(pA0,pA1);
  _Pragma("unroll") for(int r=0;r<16;++r)pA1[r]=__builtin_amdgcn_exp2f(pA1[r]);
  WAIT_BAR(0);
  DMA_K(3,0);DMA_V(1,SLOTB);
  ROT();
  kload8(kf,kp0+sl_cur);
  WAIT_BAR(2);
  s16x4 vlo[8],vhi[8]; u32x4 pw0,pw1,pw2,pw3;
  #define PKW(P,B) cvtpk_s(P[B],P[B+1])
  #define PAF(k) __builtin_bit_cast(bf16x8,pw##k)
  #define VFR(i) (bf16x8){vlo[i][0],vlo[i][1],vlo[i][2],vlo[i][3],vhi[i][0],vhi[i][1],vhi[i][2],vhi[i][3]}
  #define PIN(x) asm volatile("":"+v"(x))
  #define MX3(a,b,c) __builtin_fmaxf(__builtin_fmaxf((a),(b)),(c))
  #define GAPA(MF,A0,A1,A2,A3,W0,W1,PW) do{ MF; sacc+=A0; sacc+=A1; sacc+=A2; sacc+=A3; PIN(sacc); W0; W1; PIN(PW); SBAR(); }while(0)
  #define EX(v) __builtin_amdgcn_exp2f(v)
  #define GAPB(MF,X,B) do{ MF; X[B]=EX(X[B]); X[B+1]=EX(X[B+1]); X[B+2]=EX(X[B+2]); X[B+3]=EX(X[B+3]); PIN(X); SBAR(); }while(0)
  #define VRD(i) do{ vlo[i]=vtr(vp_+(((i)>>2)*4096+((i)&3)*1024)); vhi[i]=vtr(vp_+(((i)>>2)*4096+((i)&3)*1024+512)); }while(0)
  #define KRD(G,j) do{ if(G){ kload2(kf,kp0+sl_next,j); SBAR(); } }while(0)
  #define STEP(C0,C1,P0,P1,t,GK,GV,GL) do{ SBAR(); \
    fkinit(C0,C1,fp0+(t)*256,qoff); SBAR(); \
    const lds_cptr vp_=vp0+sl_prev; \
    VRD(0); SBAR(); float sacc=(P0[0]+P0[1]); \
    GAPA(C0=__builtin_amdgcn_mfma_f32_32x32x16_bf16(kf[0],qr[0],C0,0,0,0), P0[2],P0[3],P0[4],P0[5],     pw0[0]=PKW(P0,0), pw0[1]=PKW(P0,2), pw0); \
    VRD(4); SBAR(); GAPA(C1=__builtin_amdgcn_mfma_f32_32x32x16_bf16(kf[1],qr[0],C1,0,0,0), P0[6],P0[7],P0[8],P0[9],     pw0[2]=PKW(P0,4), pw0[3]=PKW(P0,6), pw0); \
    VRD(1); SBAR(); GAPA(C0=__builtin_amdgcn_mfma_f32_32x32x16_bf16(kf[2],qr[1],C0,0,0,0),   P0[10],P0[11],P0[12],P0[13], pw1[0]=PKW(P0,8), pw1[1]=PKW(P0,10), pw1); \
    VRD(5); SBAR(); GAPA(C1=__builtin_amdgcn_mfma_f32_32x32x16_bf16(kf[3],qr[1],C1,0,0,0),   P0[14],P0[15],P1[0],P1[1],   pw1[2]=PKW(P0,12),pw1[3]=PKW(P0,14), pw1); \
    VRD(2); SBAR(); GAPA(C0=__builtin_amdgcn_mfma_f32_32x32x16_bf16(kf[4],qr[2],C0,0,0,0),   P1[2],P1[3],P1[4],P1[5],     pw2[0]=PKW(P1,0), pw2[1]=PKW(P1,2), pw2); \
    VRD(6); SBAR(); GAPA(C1=__builtin_amdgcn_mfma_f32_32x32x16_bf16(kf[5],qr[2],C1,0,0,0),   P1[6],P1[7],P1[8],P1[9],     pw2[2]=PKW(P1,4), pw2[3]=PKW(P1,6), pw2); \
    VRD(3); SBAR(); GAPA(C0=__builtin_amdgcn_mfma_f32_32x32x16_bf16(kf[6],qr[3],C0,0,0,0),   P1[10],P1[11],P1[12],P1[13], pw3[0]=PKW(P1,8), pw3[1]=PKW(P1,10), pw3); \
    VRD(7); SBAR(); GAPA(C1=__builtin_amdgcn_mfma_f32_32x32x16_bf16(kf[7],qr[3],C1,0,0,0),   P1[14],P1[15],0.f,0.f,       pw3[2]=PKW(P1,12),pw3[3]=PKW(P1,14), pw3); \
    l_reg+=sacc; \
    if(GK){DMA_K((t)+3,sl_cur);} if(GV){DMA_V((t)+1,sl_next);} \
    CMASK(C0,C1,t); \
    { float a=MX3(C0[0],C0[1],C1[0]),b=MX3(C0[2],C0[3],C1[1]); a=MX3(a,C1[2],C1[3]); \
      _Pragma("unroll") for(int r=4;r<16;r+=4){a=MX3(a,C0[r],C0[r+1]);b=MX3(b,C0[r+2],C0[r+3]);a=MX3(a,C1[r],C1[r+1]);b=MX3(b,C1[r+2],C1[r+3]);} \
      float rm=__builtin_fmaxf(a,b); { auto rr=__builtin_amdgcn_permlane32_swap(__float_as_uint(rm),__float_as_uint(rm),false,false); rm=__builtin_fmaxf(__uint_as_float(rr[0]),__uint_as_float(rr[1])); } \
      resc=false; \
      if(__builtin_expect(__any(rm>(float)THRL),0)){ const float dl=__builtin_fmaxf(rm,0.f); mhat+=dl; \
        _Pragma("unroll") for(int r=0;r<16;++r){C0[r]-=dl;C1[r]-=dl;} \
        qoff=F2q-mhat; \
        const float f=__builtin_amdgcn_exp2f(-dl); l_reg*=f; if(hi==0)wsf[r32]=f; resc=true; } } \
    SBAR(); \
    GAPB(o[0]=__builtin_amdgcn_mfma_f32_32x32x16_bf16(PAF(0),VFR(0),o[0],0,0,0), C0,0); \
    GAPB(o[1]=__builtin_amdgcn_mfma_f32_32x32x16_bf16(PAF(0),VFR(4),o[1],0,0,0), C0,4); \
    KRD(GL,0); GAPB(o[0]=__builtin_amdgcn_mfma_f32_32x32x16_bf16(PAF(1),VFR(1),o[0],0,0,0), C0,8); \
    KRD(GL,1); GAPB(o[1]=__builtin_amdgcn_mfma_f32_32x32x16_bf16(PAF(1),VFR(5),o[1],0,0,0), C0,12); \
    KRD(GL,2); GAPB(o[0]=__builtin_amdgcn_mfma_f32_32x32x16_bf16(PAF(2),VFR(2),o[0],0,0,0), C1,0); \
    KRD(GL,3); GAPB(o[1]=__builtin_amdgcn_mfma_f32_32x32x16_bf16(PAF(2),VFR(6),o[1],0,0,0), C1,4); \
    GAPB(o[0]=__builtin_amdgcn_mfma_f32_32x32x16_bf16(PAF(3),VFR(3),o[0],0,0,0), C1,8); \
    GAPB(o[1]=__builtin_amdgcn_mfma_f32_32x32x16_bf16(PAF(3),VFR(7),o[1],0,0,0), C1,12); \
    }while(0)
  int t=1;
  #undef CMASK
  #define CMASK(P0,P1,t) do{}while(0)
  for(;t+5<NT;t+=2){
    STEP(pB0,pB1,pA0,pA1,t,true,true,true);     WAIT_BAR(2); RESC(); ROT();
    STEP(pA0,pA1,pB0,pB1,t+1,true,true,true);   WAIT_BAR(2); RESC(); ROT();
  }
  #undef CMASK
  #define CMASK(P0,P1,t) do{int jb_=(t)-(NT-4); if(jb_>=0)cmask(P0,P1,jb_,qrel,hi);}while(0)
  #define ENDW(tt) do{ if((tt)+3<NT){WAIT_BAR(2);} else if((tt)+2<NT){WAIT_BAR(1);} else {WAIT_BAR(0);} }while(0)
  for(;t+1<NT;t+=2){
    STEP(pB0,pB1,pA0,pA1,t,(t+3<NT),(t+1<NT),(t+1<NT));       ENDW(t);   RESC(); ROT();
    STEP(pA0,pA1,pB0,pB1,t+1,(t+4<NT),(t+2<NT),(t+2<NT));     ENDW(t+1); RESC(); ROT();
  }
  STEP(pB0,pB1,pA0,pA1,NT-1,false,false,false); RESC();
  { float sacc=pB0[0]+pB0[1]; _Pragma("unroll") for(int r=2;r<16;++r)sacc+=pB0[r]; _Pragma("unroll") for(int r=0;r<16;++r)sacc+=pB1[r]; l_reg+=sacc;
    pw0=(u32x4){PKW(pB0,0),PKW(pB0,2),PKW(pB0,4),PKW(pB0,6)};pw1=(u32x4){PKW(pB0,8),PKW(pB0,10),PKW(pB0,12),PKW(pB0,14)};pw2=(u32x4){PKW(pB1,0),PKW(pB1,2),PKW(pB1,4),PKW(pB1,6)};pw3=(u32x4){PKW(pB1,8),PKW(pB1,10),PKW(pB1,12),PKW(pB1,14)};
    SBAR(); pv(o,vb0+sl_cur,PAF(0),PAF(1),PAF(2),PAF(3)); }
  #undef PKW
  #undef PAF
  #undef VFR
  #undef PIN
  #undef MX3
  #undef GAPA
  #undef GAPB
  #undef EX
  #undef VRD
  #undef KRD
  #undef STEP
  #undef ENDW
  {auto rr=__builtin_amdgcn_permlane32_swap(__float_as_uint(l_reg),__float_as_uint(l_reg),false,false);l_reg=__uint_as_float(rr[0])+__uint_as_float(rr[1]);}
  if(hi==0)wsf[32+r32]=l_reg;asm volatile("s_waitcnt lgkmcnt(0)":::"memory");
  float rli[16];
  #pragma unroll
  for(int r=0;r<16;++r)rli[r]=__builtin_amdgcn_rcpf(wsf[32+crow(r,hi)]);
  bf16*Ow=O+(rowbase+q0+wid*QBLK)*OPITCH+h*D;
  { bf16*stg=(bf16*)(shm+LDS_OST)+wid*2048;
    #pragma unroll
    for(int r=0;r<16;++r){const int orow=crow(r,hi);
      #pragma unroll
      for(int d0=0;d0<2;++d0)stg[orow*64+d0*32+r32]=__float2bfloat16(o[d0][r]*rli[r]);}
    asm volatile("s_waitcnt lgkmcnt(0)":::"memory");
    #pragma unroll
    for(int i=0;i<4;++i){const int row=i*8+(lane>>3),ch=lane&7; const u32x4 v=*(const u32x4*)(stg+row*64+ch*8); ATTN_STORE16(Ow+(long)row*OPITCH+ch*8,v);} }
  asm volatile("s_waitcnt lgkmcnt(0)\n\ts_barrier":::"memory");
  #undef DMA_K
  #undef DMA_V
  #undef CMASK
  #undef START
  #undef RESC
  #undef ROT
}
constexpr int ATTN_LDS_BYTES=LDS_BYTES;
struct AttnTensors { const bf16* Q; const bf16* K; const bf16* V; const float* F2; bf16* O; };
struct AttnUnit { int bh; int qb; };
struct StaticOrder {
  int vcu;
  __device__ __forceinline__ explicit StaticOrder(int grid,int block):vcu((block%8)*(grid/8)+block/8){}
  __device__ __forceinline__ bool next(int i,AttnUnit&u)const{ if(i>=2||vcu>=256)return false; const int s=vcu&15; u.bh=vcu>>4; u.qb=(i==0)?s:31-s; return true; }
  __device__ __forceinline__ void a_ready(const AttnUnit&)const{}
  __device__ __forceinline__ void done(const AttnUnit&)const{}
};
template<class Sched,int THRL=8> __device__ __forceinline__ void attn_phase(char*lds,const AttnTensors&T,const Sched&S){
  AttnUnit u;
  for(int i=0;S.next(i,u);++i){ S.a_ready(u); attn_unit<THRL>(u.bh/NHEAD,u.bh%NHEAD,u.qb,T.Q,T.K,T.V,T.F2,T.O,lds); S.done(u); }
}
#undef SBAR
#undef WAIT_BAR
}
typedef float f32x4m __attribute__((ext_vector_type(4)));
__device__ __forceinline__ float bf2f(unsigned short b) { return __uint_as_float((unsigned)b << 16); }
__device__ __forceinline__ void gla_chunk_item(Frame& F, int item) {
    const int h = item & 3, c = (item >> 2) & 127, b = item >> 9, tid = F.tid, lane = F.lane, wid = F.wave;
    const size_t row0 = (size_t)b * SEQ + c * 64;
    LAS float* L = (LAS float*)(F.lds + RING_OFF); LAS float* glw = L; LAS float* la = L + 1024; LAS float* seg = L + 5120; LAS float* kd = L + 5632; LAS float* vs = L + 9728;
    const bf16* P1 = (const bf16*)(F.ws + WS_P1); const bf16* GK = P1 + (size_t)3 * M * 512 + (size_t)M * 256; const bf16* GV = P1 + (size_t)4 * M * 512;
    const float* GLOW = (const float*)(F.ws + WS_GLOW);
    const int dk = tid & 63, tq = tid >> 6;
    for (int i = tid; i < 256; i += 512) ((LAS f32x4m*)glw)[i] = ((const GAS f32x4m*)(GLOW + row0 * 16))[i];
#pragma unroll
    for (int j = 0; j < 2; ++j) { const int ch = tid + 512 * j, r = ch >> 4, c8 = (ch & 15) * 8; const v4u raw = *(const GAS v4u*)(GV + (row0 + r) * 512 + h * 128 + c8);
        LAS float* d = vs + r * 128 + c8;
        d[0] = __uint_as_float(raw.x << 16); d[1] = __uint_as_float(raw.x & 0xffff0000u); d[2] = __uint_as_float(raw.y << 16); d[3] = __uint_as_float(raw.y & 0xffff0000u);
        d[4] = __uint_as_float(raw.z << 16); d[5] = __uint_as_float(raw.z & 0xffff0000u); d[6] = __uint_as_float(raw.w << 16); d[7] = __uint_as_float(raw.w & 0xffff0000u); }
    float gu[16];
#pragma unroll
    for (int r = 0; r < 16; ++r) gu[r] = F.gup[r * 256 + h * 64 + dk];
    const float gbv = F.gbias[h * 64 + dk];
    float kv[8];
#pragma unroll
    for (int i = 0; i < 8; ++i) kv[i] = bf2f(GK[(row0 + 8 * tq + i) * 256 + h * 64 + dk]);
    __syncthreads();
    float run = 0.f;
#pragma unroll
    for (int i = 0; i < 8; ++i) { const int t = 8 * tq + i; float s = gbv;
#pragma unroll
        for (int r = 0; r < 16; ++r) s = fmaf(glw[t * 16 + r], gu[r], s);
        run += log_sigmoid_f(s) * (1.f / 16.f); la[t * 64 + dk] = run; }
    seg[tq * 64 + dk] = run;
    __syncthreads();
    float off = 0.f, total = 0.f;
#pragma unroll
    for (int q = 0; q < 8; ++q) { const float sv = seg[q * 64 + dk]; total += sv; if (q < tq) off += sv; }
#pragma unroll
    for (int i = 0; i < 8; ++i) { const int t = 8 * tq + i; kd[t * 64 + dk] = kv[i] * __expf(total - (la[t * 64 + dk] + off)); }
    if (tq == 0) ((float*)(F.ws + WS_DECAY))[((size_t)(b * 128 + c) * 4 + h) * 64 + dk] = __expf(total);
    __syncthreads();
    const int mb = wid & 3, nb0 = (wid >> 2) * 4, l15 = lane & 15, l4 = lane >> 4;
    f32x4m acc[4];
#pragma unroll
    for (int n = 0; n < 4; ++n) acc[n] = (f32x4m){0.f, 0.f, 0.f, 0.f};
#pragma unroll 4
    for (int ks = 0; ks < 16; ++ks) { const int t = 4 * ks + l4; const float a = kd[t * 64 + mb * 16 + l15];
#pragma unroll
        for (int n = 0; n < 4; ++n) acc[n] = __builtin_amdgcn_mfma_f32_16x16x4f32(a, vs[t * 128 + (nb0 + n) * 16 + l15], acc[n], 0, 0, 0); }
    float* up = (float*)(F.ws + WS_UPD) + ((size_t)(b * 128 + c) * 4 + h) * 64 * 128;
#pragma unroll
    for (int n = 0; n < 4; ++n)
#pragma unroll
        for (int r = 0; r < 4; ++r) up[(mb * 16 + 4 * l4 + r) * 128 + (nb0 + n) * 16 + l15] = acc[n][r];
    __syncthreads();
}
__device__ __forceinline__ void fscan_item(Frame& F, int bh) {
    const int b = bh >> 3, h = bh & 7, tid = F.tid, lane = F.lane, wid = F.wave;
    const float* src = (const float*)(F.ws + WS_FLT) + (size_t)h * M + (size_t)b * SEQ + 16 * tid;
    f32x4m v[4];
#pragma unroll
    for (int j = 0; j < 4; ++j) v[j] = ((const GAS f32x4m*)src)[j];
    double loc[16]; double run = 0.0;
#pragma unroll
    for (int j = 0; j < 4; ++j)
#pragma unroll
        for (int i = 0; i < 4; ++i) { run += (double)v[j][i]; loc[4 * j + i] = run; }
    double inc = run;
#pragma unroll
    for (int o = 1; o < 64; o <<= 1) { const double up = __shfl_up(inc, o); if (lane >= o) inc += up; }
    LAS double* wt = (LAS double*)(F.lds + RING_OFF);
    if (lane == 63) wt[wid] = inc;
    __syncthreads();
    double base = inc - run;
#pragma unroll
    for (int w = 0; w < 8; ++w) if (w < wid) base += wt[w];
    float* dst = (float*)(F.ws + WS_F2) + (size_t)bh * SEQ + 16 * tid;
#pragma unroll
    for (int j = 0; j < 4; ++j) { f32x4m o;
#pragma unroll
        for (int i = 0; i < 4; ++i) o[i] = (float)(base + loc[4 * j + i]);
        ((GAS f32x4m*)dst)[j] = o; }
    __syncthreads();
}
__device__ __forceinline__ void gla_scan(Frame& F) {
    if (F.tid >= 256) return;
    const int nel = BATCH * GH * 64 * 128;
    for (int id = F.vcu * 256 + F.tid; id < nel; id += F.G * 256) {
        const int dv = id & 127, dkk = (id >> 7) & 63, h = (id >> 13) & 3, b = id >> 15;
        float* up = (float*)(F.ws + WS_UPD) + ((size_t)(b * 128) * 4 + h) * 64 * 128 + dkk * 128 + dv; const float* dc = (const float*)(F.ws + WS_DECAY) + ((size_t)(b * 128) * 4 + h) * 64 + dkk;
        float st = 0.f;
        for (int c0 = 0; c0 < 128; c0 += 16) { float u[16], d[16];
#pragma unroll
            for (int j = 0; j < 16; ++j) { u[j] = up[(size_t)(c0 + j) * 4 * 64 * 128]; d[j] = dc[(size_t)(c0 + j) * 4 * 64]; }
#pragma unroll
            for (int j = 0; j < 16; ++j) { st = fmaf(d[j], st, u[j]); up[(size_t)(c0 + j) * 4 * 64 * 128] = st; } }
    }
}
__device__ __forceinline__ void gla_out_item(Frame& F, int item) {
    const int h = item & 3, c = (item >> 2) & 127, b = item >> 9, tid = F.tid, lane = F.lane, wid = F.wave;
    const size_t row0 = (size_t)b * SEQ + c * 64;
    LAS float* L = (LAS float*)(F.lds + RING_OFF); LAS float* qs = L; LAS float* st = L + 4160; LAS float* ssq = L + 12352; LAS float* ob = L + 12480;
    const bf16* P1 = (const bf16*)(F.ws + WS_P1); const bf16* GQ = P1 + (size_t)3 * M * 512; const bf16* GO = P1 + (size_t)5 * M * 512;
    const float* sp = (const float*)(F.ws + WS_UPD) + ((size_t)(b * 128 + c) * 4 + h) * 64 * 128;
#pragma unroll
    for (int j = 0; j < 4; ++j) ((LAS f32x4m*)st)[tid + 512 * j] = ((const GAS f32x4m*)sp)[tid + 512 * j];
    { const int r = tid >> 3, c8 = (tid & 7) * 8; const v4u raw = *(const GAS v4u*)(GQ + (row0 + r) * 256 + h * 64 + c8); LAS float* d = qs + r * 65 + c8;
      d[0] = __uint_as_float(raw.x << 16); d[1] = __uint_as_float(raw.x & 0xffff0000u); d[2] = __uint_as_float(raw.y << 16); d[3] = __uint_as_float(raw.y & 0xffff0000u);
      d[4] = __uint_as_float(raw.z << 16); d[5] = __uint_as_float(raw.z & 0xffff0000u); d[6] = __uint_as_float(raw.w << 16); d[7] = __uint_as_float(raw.w & 0xffff0000u); }
    __syncthreads();
    const int mb = wid & 3, nb0 = (wid >> 2) * 4, l15 = lane & 15, l4 = lane >> 4;
    f32x4m acc[4];
#pragma unroll
    for (int n = 0; n < 4; ++n) acc[n] = (f32x4m){0.f, 0.f, 0.f, 0.f};
#pragma unroll 4
    for (int ks = 0; ks < 16; ++ks) { const int kk = 4 * ks + l4; const float a = qs[(mb * 16 + l15) * 65 + kk];
#pragma unroll
        for (int n = 0; n < 4; ++n) acc[n] = __builtin_amdgcn_mfma_f32_16x16x4f32(a, st[kk * 128 + (nb0 + n) * 16 + l15], acc[n], 0, 0, 0); }
#pragma unroll
    for (int r = 0; r < 4; ++r) { float s = 0.f;
#pragma unroll
        for (int n = 0; n < 4; ++n) s += acc[n][r] * acc[n][r];
        s += __shfl_xor(s, 1); s += __shfl_xor(s, 2); s += __shfl_xor(s, 4); s += __shfl_xor(s, 8);
        if (l15 == 0) ssq[(wid >> 2) * 64 + mb * 16 + 4 * l4 + r] = s;
#pragma unroll
        for (int n = 0; n < 4; ++n) ob[(mb * 16 + 4 * l4 + r) * 132 + (nb0 + n) * 16 + l15] = acc[n][r]; }
    __syncthreads();
    { const int t = tid >> 3, d0 = (tid & 7) * 16; const float rs = 1.f / sqrtf((ssq[t] + ssq[64 + t]) * (1.f / 128.f) + EPS);
      const v4u g0 = *(const GAS v4u*)(GO + (row0 + t) * 512 + h * 128 + d0), g1 = *(const GAS v4u*)(GO + (row0 + t) * 512 + h * 128 + d0 + 8);
      const unsigned gw[8] = {g0.x, g0.y, g0.z, g0.w, g1.x, g1.y, g1.z, g1.w}; unsigned ow[8];
#pragma unroll
      for (int j = 0; j < 8; ++j) { const float ga = __uint_as_float(gw[j] << 16), gb2 = __uint_as_float(gw[j] & 0xffff0000u);
          const float oa = ob[t * 132 + d0 + 2 * j] * rs * F.gng[d0 + 2 * j] * (ga * __builtin_amdgcn_rcpf(1.f + __expf(-ga)));
          const float obv = ob[t * 132 + d0 + 2 * j + 1] * rs * F.gng[d0 + 2 * j + 1] * (gb2 * __builtin_amdgcn_rcpf(1.f + __expf(-gb2)));
          ow[j] = pk2(oa, obv); }
      bf16* dst = (bf16*)(F.ws + WS_CAT) + (row0 + t) * D + 512 + h * 128 + d0;
      *(GAS v4u*)dst = (v4u){ow[0], ow[1], ow[2], ow[3]}; *(GAS v4u*)(dst + 8) = (v4u){ow[4], ow[5], ow[6], ow[7]}; }
    __syncthreads();
}
constexpr int RW_LD = 1028;
constexpr int RT_RW = 0, RT_LOG = 32 * RW_LD * 4, RT_HIST = RT_LOG + 64 * 33 * 4, RT_BASE = RT_HIST + 128, RT_END = RT_BASE + 128;
static_assert(RT_END + 3 * 1024 <= LDSCTL_OFF, "router LDS map");
__device__ __forceinline__ void p6_router(Frame& F) {
    const int tid = F.tid, wid = F.wave; int lane = F.lane; asm volatile("" : "+v"(lane));
    LAS float* rwt = (LAS float*)(F.lds + RT_RW); LAS float* lg = (LAS float*)(F.lds + RT_LOG); LAS int* hist = (LAS int*)(F.lds + RT_HIST); LAS int* base = (LAS int*)(F.lds + RT_BASE);
    for (int it = 0; it < 64; ++it) { const int i = tid + 512 * it, k = i >> 5, e = i & 31; rwt[e * RW_LD + k] = F.rw[i]; }
    if (tid < 32) hist[tid] = 0;
    __syncthreads();
    const float* H = (const float*)(F.ws + WS_H); bf16* XN = (bf16*)(F.ws + WS_XN);
    f32x4 gv[4];
#pragma unroll
    for (int j = 0; j < 4; ++j) gv[j] = ((const GAS f32x4*)F.n2g)[lane + 64 * j];
    for (int rr = 0; rr < 8; ++rr) {
        const int rl = wid * 8 + rr, m = F.vcu * 64 + rl;
        const GAS f32x4* xr = (const GAS f32x4*)(H + (size_t)m * D) + lane;
        f32x4 v[4]; float s = 0.f;
#pragma unroll
        for (int j = 0; j < 4; ++j) { v[j] = xr[64 * j]; s += (v[j].x * v[j].x + v[j].y * v[j].y) + (v[j].z * v[j].z + v[j].w * v[j].w); }
        const float rstd = 1.f / sqrtf(wave_sum(s) * (1.f / D) + EPS);
        GAS unsigned long long* o8 = (GAS unsigned long long*)(XN + (size_t)m * D) + lane;
#pragma unroll
        for (int j = 0; j < 4; ++j) { v[j] = v[j] * rstd * gv[j]; o8[64 * j] = (unsigned long long)pk2(v[j].x, v[j].y) | ((unsigned long long)pk2(v[j].z, v[j].w) << 32); }
        float a[32];
#pragma unroll
        for (int e = 0; e < 32; ++e) { float t = 0.f;
#pragma unroll
            for (int j = 0; j < 4; ++j) { const f32x4 w = *(const LAS f32x4*)(rwt + e * RW_LD + 256 * j + 4 * lane); t += (v[j].x * w.x + v[j].y * w.y) + (v[j].z * w.z + v[j].w * w.w); }
            a[e] = t; if ((e & 3) == 3) asm volatile("" ::: "memory"); }
        const float tot = bfly32(a, lane);
        if ((lane & 1) == 0) lg[rl * 33 + (lane >> 1)] = tot + F.rb[lane >> 1];
    }
    __syncthreads();
    LAS int* selL = (LAS int*)(F.lds + RT_END); LAS int* rankL = selL + 256; LAS float* gtL = (LAS float*)(rankL + 256);
    if (tid < 64) {
        float v[32];
#pragma unroll
        for (int e = 0; e < 32; ++e) v[e] = lg[tid * 33 + e];
        int sel[4] = {0, 0, 0, 0}; float sv[4];
#pragma unroll
        for (int k = 0; k < 4; ++k) { int bi = 0; float bv = -INFINITY;
#pragma unroll
            for (int e = 0; e < 32; ++e) { bool taken = false;
#pragma unroll
                for (int kk = 0; kk < 4; ++kk) if (kk < k && sel[kk] == e) taken = true;
                if (!taken && v[e] > bv) { bv = v[e]; bi = e; } }
            sel[k] = bi; sv[k] = bv; }
        float gt[4], sum = 0.f;
#pragma unroll
        for (int k = 0; k < 4; ++k) { gt[k] = __expf(sv[k] - sv[0]); sum += gt[k]; }
        const float inv = 1.f / sum;
#pragma unroll
        for (int k = 0; k < 4; ++k) { selL[tid * 4 + k] = sel[k]; gtL[tid * 4 + k] = gt[k] * inv; rankL[tid * 4 + k] = __hip_atomic_fetch_add(hist + sel[k], 1, __ATOMIC_RELAXED, __HIP_MEMORY_SCOPE_WORKGROUP); }
    }
    __syncthreads();
    if (tid < 32) { const int hcount = hist[tid]; base[tid] = hcount ? (int)__hip_atomic_fetch_add(F.ctl + CW_ECNT + 64 * tid, (unsigned)hcount, RLX_AGENT) : 0; }
    __syncthreads();
    if (tid < 256) { const int m = F.vcu * 64 + (tid >> 2), e = selL[tid], idx = base[e] + rankL[tid];
        ((int*)(F.ws + WS_TOKL))[(size_t)e * ECAP + idx] = m; ((int*)(F.ws + WS_PIDX))[m * 4 + (tid & 3)] = idx; ((int*)(F.ws + WS_EIDX))[m * 4 + (tid & 3)] = e; ((float*)(F.ws + WS_GATE))[m * 4 + (tid & 3)] = gtL[tid]; }
}
constexpr int MOE_MAX_UNITS = 26;
__device__ __forceinline__ void moe_tables(Frame& F) {
    LAS int* tab = (LAS int*)(F.lds + EXTRA_OFF);
    __syncthreads();
    if (F.tid < 32) tab[128 + F.tid] = (int)__hip_atomic_load(F.ctl + CW_ECNT + 64 * F.tid, RLX_AGENT);
    __syncthreads();
    if (F.tid == 0) { int a = 0; for (int e = 0; e < 32; ++e) { tab[e] = a; tab[64 + e] = a * 256; a += (tab[128 + e] + 255) >> 8; } tab[32] = a; }
    __syncthreads();
}
template <class Sched> __device__ __forceinline__ void moe_fill_toks(Frame& F, const Sched& S) {
    LAS int* tab = (LAS int*)(F.lds + EXTRA_OFF); LAS int* toks = tab + 256; const int* TOKL = (const int*)(F.ws + WS_TOKL);
    pg8::Unit u;
    for (int i = 0; i < MOE_MAX_UNITS && S.next(i, u); ++i) if (F.tid < 256) { const int idx = (u.pm & 0xffff) * 256 + F.tid; toks[i * 256 + F.tid] = (idx < tab[128 + u.e]) ? TOKL[(size_t)u.e * ECAP + idx] : 0; }
    __syncthreads();
}
__device__ __forceinline__ void p9_combine(Frame& F) {
    int lane = F.lane; asm volatile("" : "+v"(lane)); const LAS int* tab = (const LAS int*)(F.lds + EXTRA_OFF);
    const float* H = (const float*)(F.ws + WS_H); const bf16* Y = (const bf16*)(F.ws + WS_Y);
    const int* PIDX = (const int*)(F.ws + WS_PIDX); const int* EIDX = (const int*)(F.ws + WS_EIDX); const float* GATE = (const float*)(F.ws + WS_GATE);
    f32x4 gv[4];
#pragma unroll
    for (int j = 0; j < 4; ++j) gv[j] = ((const GAS f32x4*)F.fg)[lane + 64 * j];
    const int gw = F.vcu * NWAVES + F.wave, NGW = F.G * NWAVES;
    for (int m = gw; m < M; m += NGW) {
        f32x4 v[4];
#pragma unroll
        for (int j = 0; j < 4; ++j) v[j] = ((const GAS f32x4*)(H + (size_t)m * D))[lane + 64 * j];
#pragma unroll
        for (int k = 0; k < 4; ++k) { const int e = EIDX[m * 4 + k]; const size_t slot = (size_t)tab[64 + e] + PIDX[m * 4 + k]; const float g = GATE[m * 4 + k];
            const GAS unsigned long long* yr = (const GAS unsigned long long*)(Y + slot * D) + lane;
#pragma unroll
            for (int j = 0; j < 4; ++j) { const unsigned long long w = yr[64 * j]; const unsigned lo = (unsigned)w, hi = (unsigned)(w >> 32);
                v[j].x = fmaf(g, __uint_as_float(lo << 16), v[j].x); v[j].y = fmaf(g, __uint_as_float(lo & 0xffff0000u), v[j].y);
                v[j].z = fmaf(g, __uint_as_float(hi << 16), v[j].z); v[j].w = fmaf(g, __uint_as_float(hi & 0xffff0000u), v[j].w); } }
        float s = 0.f;
#pragma unroll
        for (int j = 0; j < 4; ++j) s += (v[j].x * v[j].x + v[j].y * v[j].y) + (v[j].z * v[j].z + v[j].w * v[j].w);
        const float rstd = 1.f / sqrtf(wave_sum(s) * (1.f / D) + EPS);
#pragma unroll
        for (int j = 0; j < 4; ++j) ((GAS f32x4*)(F.out + (size_t)m * D))[lane + 64 * j] = v[j] * rstd * gv[j];
    }
}

struct Args { const float* in[16]; float* out; unsigned char* ws; int ph_lo, ph_hi; };
constexpr int N_PHASES = 10;
__global__ void __launch_bounds__(NWAVES * 64, 2) mk_fwd(Args args) {
    extern __shared__ __attribute__((aligned(16))) unsigned char lds[];
    Frame F;
    F.lds = (LAS unsigned char*)lds; F.MISC = (volatile LAS unsigned*)(F.lds + MISC_OFF);
    F.tid = threadIdx.x; F.lane = F.tid & 63; F.wave = __builtin_amdgcn_readfirstlane(F.tid >> 6);
    F.G = gridDim.x; { const int bx = blockIdx.x; F.vcu = (F.G % 8 == 0) ? (bx % 8) * (F.G / 8) + bx / 8 : bx; }
    unsigned char* ws = args.ws; F.ws = ws; F.ctl = (gu32*)(ws + WS_CTL);
    F.x = args.in[0]; F.n1g = args.in[1]; F.w_in = args.in[2]; F.fbias = args.in[3]; F.gup = args.in[4]; F.gbias = args.in[5]; F.gng = args.in[6]; F.w_out = args.in[7];
    F.n2g = args.in[8]; F.rw = args.in[9]; F.rb = args.in[10]; F.ewi = args.in[11]; F.ebi = args.in[12]; F.ewo = args.in[13]; F.ebo = args.in[14]; F.fg = args.in[15]; F.out = args.out;
    for (int u = F.tid; u < (LDS_BYTES - LDSCTL_OFF) / 4; u += NWAVES * 64) ((LAS unsigned*)(F.lds + LDSCTL_OFF))[u] = 0u;
    __syncthreads();
    const int lo = args.ph_lo, hi = args.ph_hi;
    const bool one_phase = (hi - lo) == 1;
    XcdBarrier bar; bar.bar = (unsigned*)(F.ctl + CW_BAR); bar.x = 0; bar.st = nullptr;
    if (!one_phase) bar = xcd_barrier_post((unsigned*)(F.ctl + CW_BAR), F.MISC + 8);
#define IN(k) (lo <= (k) && (k) < hi)
#define BOTH(k) (IN(k) && IN((k) + 1))
#define GRID_BAR() xcd_barrier(bar)
#define REFRESH() do { int t_ = threadIdx.x; asm volatile("" : "+v"(t_)); F.tid = t_; F.lane = t_ & 63; } while (0)

#ifndef SKIP_P0
    if (IN(0)) { REFRESH(); p0_prologue(F); if (BOTH(0)) GRID_BAR(); }
#endif
#ifndef SKIP_P1
    if (IN(1)) { REFRESH();
        pg8::Gemm g{(const pg8::bf16_t*)(ws + WS_XN), (const pg8::bf16_t*)(ws + WS_WIN), M, NPROJ, D}; pg8::StaticOrder S; S.init(M, NPROJ, F.G, (int)blockIdx.x);
        pg8::EpiRoute E{(pg8::bf16_t*)(ws + WS_P1), M, C2};
        pg8::gemm_phase<pg8::EpiRoute, pg8::StaticOrder, true, true>(F.lds + RING_OFF, g, S, E);
        if (BOTH(1)) GRID_BAR();
    }
#endif
    if (IN(2)) { REFRESH();
        if (F.vcu < BATCH * FH) fscan_item(F, F.vcu);
        for (int it = F.vcu; it < BATCH * 128 * GH; it += F.G) gla_chunk_item(F, it);
        if (BOTH(2)) GRID_BAR();
    }
    if (IN(3)) { REFRESH(); gla_scan(F); if (BOTH(3)) GRID_BAR(); }
    if (IN(4)) { REFRESH();
        { const bf16* P1 = (const bf16*)(ws + WS_P1);
          const attn_body::AttnTensors AT{(const attn_body::bf16*)P1, (const attn_body::bf16*)(P1 + (size_t)M * 512), (const attn_body::bf16*)(P1 + (size_t)2 * M * 512), (const float*)(ws + WS_F2), (attn_body::bf16*)(ws + WS_CAT)};
          const attn_body::StaticOrder S((int)F.G, (int)blockIdx.x);
          attn_body::attn_phase<attn_body::StaticOrder>((char*)lds + RING_OFF, AT, S); }
        __syncthreads();
        for (int it = F.vcu; it < BATCH * 128 * GH; it += F.G) gla_out_item(F, it);
        if (BOTH(4)) GRID_BAR();
    }
#ifndef SKIP_P5
    if (IN(5)) { REFRESH();
        pg8::Gemm g{(const pg8::bf16_t*)(ws + WS_CAT), (const pg8::bf16_t*)(ws + WS_WOUT), M, D, D}; pg8::StaticOrder S; S.init(M, D, F.G, (int)blockIdx.x);
        pg8::EpiResF32 E{F.x, (float*)(ws + WS_H), D};
        pg8::gemm_phase<pg8::EpiResF32, pg8::StaticOrder, false, true>(F.lds + RING_OFF, g, S, E);
        if (BOTH(5)) GRID_BAR();
    }
#endif
#ifndef SKIP_P6
    if (IN(6)) { REFRESH(); if (F.vcu < M / 64) p6_router(F); if (BOTH(6)) GRID_BAR(); }
#endif
#ifndef SKIP_P7
    if (IN(7)) { REFRESH();
        moe_tables(F);
        pg8::Gemm g{(const pg8::bf16_t*)(ws + WS_XN), (const pg8::bf16_t*)(ws + WS_E1), M, 2048, D};
        pg8::MoeOrder<true> S; S.init((const LAS int*)(F.lds + EXTRA_OFF), (const LAS int*)(F.lds + EXTRA_OFF) + 256, 8, F.G, (int)blockIdx.x);
        moe_fill_toks(F, S);
        pg8::EpiSwiglu E{(pg8::bf16_t*)(ws + WS_ACT), D, F.ebi};
        pg8::gemm_phase<pg8::EpiSwiglu, pg8::MoeOrder<true>, true, true>(F.lds + RING_OFF, g, S, E);
        if (BOTH(7)) GRID_BAR();
    }
#endif
#ifndef SKIP_P8
    if (IN(8)) { REFRESH();
        moe_tables(F);
        pg8::Gemm g{(const pg8::bf16_t*)(ws + WS_ACT), (const pg8::bf16_t*)(ws + WS_E2), M, D, D};
        pg8::MoeOrder<false> S; S.init((const LAS int*)(F.lds + EXTRA_OFF), (const LAS int*)(F.lds + EXTRA_OFF) + 256, 4, F.G, (int)blockIdx.x);
        pg8::EpiBiasBf16 E{(pg8::bf16_t*)(ws + WS_Y), D, F.ebo};
        pg8::gemm_phase<pg8::EpiBiasBf16, pg8::MoeOrder<false>, true, true>(F.lds + RING_OFF, g, S, E);
        if (BOTH(8)) GRID_BAR();
    }
#endif
#ifndef SKIP_P9
    if (IN(9)) { REFRESH(); moe_tables(F); p9_combine(F); }
#endif

#undef IN
#undef BOTH
}

static int mk_grid() {
    static int grid = 0;
    if (grid == 0) {
        int dev = 0, cus = 0;
        if (hipGetDevice(&dev) != hipSuccess || hipDeviceGetAttribute(&cus, hipDeviceAttributeMultiprocessorCount, dev) != hipSuccess) { grid = -1; return grid; }
        if (hipFuncSetAttribute((const void*)mk_fwd, hipFuncAttributeMaxDynamicSharedMemorySize, LDS_BYTES) != hipSuccess) { grid = -1; return grid; }
        int per_cu = 0;
        if (hipOccupancyMaxActiveBlocksPerMultiprocessor(&per_cu, (const void*)mk_fwd, NWAVES * 64, LDS_BYTES) != hipSuccess || per_cu < 1) { (void)hipGetLastError(); }
        grid = cus;
    }
    return grid;
}
static void mk_launch(void* const* d_in, void* d_out, void* d_ws, hipStream_t stream, int lo, int hi, int grid) {
    Args a{};
    for (int i = 0; i < 16; ++i) a.in[i] = (const float*)d_in[i];
    a.out = (float*)d_out; a.ws = (unsigned char*)d_ws; a.ph_lo = lo; a.ph_hi = hi;
    hipLaunchKernelGGL(mk_fwd, dim3(grid), dim3(NWAVES * 64), LDS_BYTES, stream, a);
}

extern "C" void kernel_launch(void* const* d_in, const int* in_sizes, int n_in, void* d_out, int out_size, void* d_ws, size_t ws_size, hipStream_t stream) {
    const int grid = mk_grid(); if (grid <= 0) return;
    if (n_in != 16 || ws_size < WS_END) return;
    (void)hipMemsetAsync((unsigned char*)d_ws + WS_CTL, 0, CTL_ZERO_BYTES, stream);
    mk_launch(d_in, d_out, d_ws, stream, 0, N_PHASES, grid);
}
```

```cpp
#include <hip/hip_runtime.h>
#include <hip/hip_bf16.h>
#include <cstdio>
#include <cstdint>
#include <cmath>


namespace pg8 {
#define PG8_LAS __attribute__((address_space(3)))
typedef unsigned short bf16_t;
typedef short bf16x8 __attribute__((ext_vector_type(8)));
typedef float f32x4 __attribute__((ext_vector_type(4)));
typedef unsigned u32x4 __attribute__((ext_vector_type(4)));
constexpr int BM = 256, BK = 64, HALF = 128, HTB = HALF * BK * 2  , STAGE_BYTES = 8 * HTB, NXCD = 8, WGM = 8;

__host__ __device__ __forceinline__ int lds_byte(int r, int c) { const int st = (r >> 4) * 2 + (c >> 5), rr = r & 15, cc = c & 31, ob = rr * 64 + cc * 2; return st * 1024 + (ob ^ (((ob >> 9) & 1) << 5)); }
__host__ __device__ __forceinline__ void stage_rc(int b, int& R, int& C) { const int st = b / 1024, sb = b % 1024, swz = sb ^ (((sb >> 9) & 1) << 5); R = (st >> 1) * 16 + swz / 64; C = (st & 1) * 32 + (swz % 64) / 2; }
__host__ __device__ __forceinline__ int perm32(int rho) { const int n = rho >> 4, i = rho & 15; return 8 * (i >> 2) + 4 * n + (i & 3); }

struct Unit { int pm, pn, e, orow; };
struct Gemm { const bf16_t* A; const bf16_t* Bt; int M, N, K; };

struct StaticOrder {
    int nM, nN, nwg, G, c;
    __host__ __device__ void init(int M, int N, int G_, int c_) { nM = M / BM; nN = N / BM; nwg = nM * nN; G = G_; c = c_; }
    __host__ __device__ bool next(int i, Unit& u) const {
        const long L = (long)i * G + c; if (L >= nwg) return false;
        int wgid = (int)L; { const int q = nwg / NXCD, r = nwg % NXCD, xcd = wgid % NXCD, off = wgid / NXCD; wgid = (xcd < r ? xcd * (q + 1) : r * (q + 1) + (xcd - r) * q) + off; }
        const int nig = WGM * nN, gid = wgid / nig, fm = gid * WGM, gsz = (nM - fm) < WGM ? (nM - fm) : WGM;
        u.pm = fm + ((wgid % nig) % gsz); u.pn = (wgid % nig) / gsz; u.e = 0; u.orow = u.pm * BM; return true;
    }
    __device__ __forceinline__ const char* a_base(const Gemm& g, const Unit& u) const { return (const char*)g.A + (size_t)u.pm * ((size_t)BM * g.K * 2); }
    __device__ __forceinline__ const char* b_base(const Gemm& g, const Unit& u) const { return (const char*)g.Bt + (size_t)u.pn * ((size_t)BM * g.K * 2); }
    __device__ __forceinline__ void voff_a(const Gemm& g, const Unit&, const int (&RA)[2], const int (&CA)[2], unsigned (&v)[2][2]) const {
#pragma unroll
        for (int h = 0; h < 2; ++h)
#pragma unroll
            for (int i = 0; i < 2; ++i) v[h][i] = (unsigned)((RA[i] + h * HALF) * g.K + CA[i]) * 2u; }
    __device__ __forceinline__ void a_ready(const Unit&) const {}
    __device__ __forceinline__ void done(const Unit&) const {}
};

template <bool GATHER_> struct MoeOrder {
    static constexpr bool GATHER = GATHER_;
    const PG8_LAS int* tab; const PG8_LAS int* toks; int nN, G, vcu, total;
    __device__ __forceinline__ void init(const PG8_LAS int* tab_, const PG8_LAS int* toks_, int nN_, int G_, int c_) {
        tab = tab_; toks = toks_; nN = nN_; G = G_; vcu = (G_ % 8 == 0) ? (c_ % 8) * (G_ / 8) + c_ / 8 : c_; total = tab_[32] * nN_; }
    __device__ __forceinline__ bool next(int i, Unit& u) const {
        const int L = i * G + vcu; if (L >= total) return false;
        const int gm = L / nN; u.pn = L % nN; int e = 0;
#pragma unroll 1
        for (int j = 1; j < 32; ++j) e += (tab[j] <= gm) ? 1 : 0;
        u.e = e; u.pm = gm - tab[e]; u.orow = tab[64 + e] + u.pm * BM; u.pm |= (i << 16);
        return true; }
    __device__ __forceinline__ const char* a_base(const Gemm& g, const Unit& u) const { return GATHER ? (const char*)g.A : (const char*)g.A + (size_t)u.orow * ((size_t)g.K * 2); }
    __device__ __forceinline__ const char* b_base(const Gemm& g, const Unit& u) const { return (const char*)g.Bt + ((size_t)u.e * g.N + (size_t)u.pn * BM) * ((size_t)g.K * 2); }
    __device__ __forceinline__ void voff_a(const Gemm& g, const Unit& u, const int (&RA)[2], const int (&CA)[2], unsigned (&v)[2][2]) const {
#pragma unroll
        for (int h = 0; h < 2; ++h)
#pragma unroll
            for (int i = 0; i < 2; ++i) { const int r = RA[i] + h * HALF; const int row = GATHER ? toks[(u.pm >> 16) * BM + r] : r; v[h][i] = (unsigned)(row * g.K + CA[i]) * 2u; } }
    __device__ __forceinline__ void a_ready(const Unit&) const {}
    __device__ __forceinline__ void done(const Unit&) const {}
};

__device__ __forceinline__ unsigned cvt_pk_bf16(float lo, float hi) { unsigned r; asm volatile("v_cvt_pk_bf16_f32 %0, %1, %2" : "=v"(r) : "v"(lo), "v"(hi)); return r; }

struct EpiRoute {
    static constexpr bool PERM = true, AFTER_DRAIN = false;
    bf16_t* O; int M; float qscale;
    __device__ __forceinline__ void operator()(const f32x4 (&acc)[2][2][4][2], const Unit& u, int wr, int wc, int fr, int fq) const {
        const int pn = u.pn; size_t off; int ld, colt; float sc = 1.f;
        if (pn < 6) { off = (size_t)(pn >> 1) * M * 512; ld = 512; colt = (pn & 1) * 256; if (pn < 2) sc = qscale; }
        else if (pn < 8) { off = (size_t)3 * M * 512 + (size_t)(pn - 6) * M * 256; ld = 256; colt = 0; if (pn == 6) sc = 0.125f; }
        else { off = (size_t)(4 + ((pn - 8) >> 1)) * M * 512; ld = 512; colt = (pn & 1) * 256; }
        bf16_t* base = O + off; const int row0 = u.orow + wr * 64 + fr, col0 = colt + wc * 32 + 8 * fq;
#pragma unroll
        for (int ai = 0; ai < 2; ++ai)
#pragma unroll
            for (int m = 0; m < 4; ++m) { bf16_t* rowp = base + (size_t)(row0 + ai * HALF + m * 16) * ld + col0;
#pragma unroll
                for (int bj = 0; bj < 2; ++bj) { const f32x4 v0 = acc[ai][bj][m][0] * sc, v1 = acc[ai][bj][m][1] * sc;
                    u32x4 w; w.x = cvt_pk_bf16(v0[0], v0[1]); w.y = cvt_pk_bf16(v0[2], v0[3]); w.z = cvt_pk_bf16(v1[0], v1[1]); w.w = cvt_pk_bf16(v1[2], v1[3]);
                    *(u32x4*)(rowp + bj * HALF) = w; } }
    }
};
struct EpiResF32 {
    static constexpr bool PERM = false, AFTER_DRAIN = false;
    const float* res; float* out; int ldc;
    __device__ __forceinline__ void operator()(const f32x4 (&acc)[2][2][4][2], const Unit& u, int wr, int wc, int fr, int fq) const {
        const int row0 = u.orow + wr * 64 + fr, col0 = u.pn * BM + wc * 32 + 4 * fq;
#pragma unroll
        for (int ai = 0; ai < 2; ++ai)
#pragma unroll
            for (int m = 0; m < 4; ++m) { const size_t off = (size_t)(row0 + ai * HALF + m * 16) * ldc + col0;
#pragma unroll
                for (int bj = 0; bj < 2; ++bj)
#pragma unroll
                    for (int n = 0; n < 2; ++n) { const f32x4 r = *(const f32x4*)(res + off + bj * HALF + n * 16); *(f32x4*)(out + off + bj * HALF + n * 16) = acc[ai][bj][m][n] + r; } }
    }
};
struct EpiSwiglu {
    static constexpr bool PERM = true, AFTER_DRAIN = false;
    bf16_t* O; int ldc; const float* bias;
    __device__ __forceinline__ void operator()(const f32x4 (&acc)[2][2][4][2], const Unit& u, int wr, int wc, int fr, int fq) const {
        const int row0 = u.orow + wr * 64 + fr, j0 = u.pn * HALF + wc * 32 + 8 * fq; const float* bg = bias + (size_t)u.e * 2048 + j0;
        f32x4 bgv[2], blv[2];
#pragma unroll
        for (int n = 0; n < 2; ++n) { bgv[n] = *(const f32x4*)(bg + 4 * n); blv[n] = *(const f32x4*)(bg + 1024 + 4 * n); }
#pragma unroll
        for (int ai = 0; ai < 2; ++ai)
#pragma unroll
            for (int m = 0; m < 4; ++m) { float a[8];
#pragma unroll
                for (int n = 0; n < 2; ++n) { const f32x4 gt = acc[ai][0][m][n] + bgv[n], ln = acc[ai][1][m][n] + blv[n];
#pragma unroll
                    for (int i = 0; i < 4; ++i) { const float g = fminf(gt[i], 7.f), l = fminf(fmaxf(ln[i], -7.f), 7.f);
                        a[4 * n + i] = (l + 1.f) * g * __builtin_amdgcn_rcpf(1.f + __builtin_amdgcn_exp2f(-1.702f * 1.4426950408889634f * g)); } }
                u32x4 w; w.x = cvt_pk_bf16(a[0], a[1]); w.y = cvt_pk_bf16(a[2], a[3]); w.z = cvt_pk_bf16(a[4], a[5]); w.w = cvt_pk_bf16(a[6], a[7]);
                *(u32x4*)(O + (size_t)(row0 + ai * HALF + m * 16) * ldc + j0) = w; }
    }
};
struct EpiBiasBf16 {
    static constexpr bool PERM = true, AFTER_DRAIN = false;
    bf16_t* O; int ldc; const float* bias;
    __device__ __forceinline__ void operator()(const f32x4 (&acc)[2][2][4][2], const Unit& u, int wr, int wc, int fr, int fq) const {
        const int row0 = u.orow + wr * 64 + fr, col0 = u.pn * BM + wc * 32 + 8 * fq; const float* bb = bias + (size_t)u.e * ldc + col0;
        f32x4 bv[2][2];
#pragma unroll
        for (int bj = 0; bj < 2; ++bj)
#pragma unroll
            for (int n = 0; n < 2; ++n) bv[bj][n] = *(const f32x4*)(bb + bj * HALF + 4 * n);
#pragma unroll
        for (int ai = 0; ai < 2; ++ai)
#pragma unroll
            for (int m = 0; m < 4; ++m) { bf16_t* rowp = O + (size_t)(row0 + ai * HALF + m * 16) * ldc + col0;
#pragma unroll
                for (int bj = 0; bj < 2; ++bj) { const f32x4 v0 = acc[ai][bj][m][0] + bv[bj][0], v1 = acc[ai][bj][m][1] + bv[bj][1];
                    u32x4 w; w.x = cvt_pk_bf16(v0[0], v0[1]); w.y = cvt_pk_bf16(v0[2], v0[3]); w.z = cvt_pk_bf16(v1[0], v1[1]); w.w = cvt_pk_bf16(v1[2], v1[3]);
                    *(u32x4*)(rowp + bj * HALF) = w; } }
    }
};

template <class Epi, class Sched, bool ALIGN_EPI = false, bool SP2 = true>
__device__ __forceinline__ void gemm_phase(PG8_LAS unsigned char* lds, const Gemm g, const Sched& S, const Epi& E) {
    const int tid = threadIdx.x, wid = __builtin_amdgcn_readfirstlane(tid >> 6), lane = tid & 63, wr = wid >> 2, wc = wid & 3, fr = lane & 15, fq = lane >> 4;
    const int K = g.K, nt = K / BK;
    unsigned voffB[2]; int RA[2], CA[2];
#pragma unroll
    for (int i = 0; i < 2; ++i) { int R, C; stage_rc(tid * 16 + i * 8192, R, C); const int Rb = Epi::PERM ? ((R & ~31) + perm32(R & 31)) : R;
        RA[i] = R; CA[i] = C; voffB[i] = (unsigned)(Rb * K + C) * 2u; }
    unsigned cvA[2][2], nvA[2][2];
    const size_t kstep = (size_t)(BK * 2);
    const size_t hstep = (size_t)HALF * K * 2;
    const size_t tstep = 2 * hstep;
    const unsigned ldsw = (unsigned)wid * 1024u;
    const int aoff = lds_byte(wr * 64 + fr, fq * 8), boff = lds_byte(wc * 32 + fr, fq * 8);
#define PG8_SA(b, h) (((b) * 2 + (h)) * HTB)
#define PG8_SB(b, h) ((4 + (b) * 2 + (h)) * HTB)
#define PG8_STAGE(bufoff, gbase, voff) do { _Pragma("unroll") for (int _i = 0; _i < 2; ++_i) \
        __builtin_amdgcn_global_load_lds((const unsigned*)((const char*)(gbase) + (voff)[_i]), (PG8_LAS unsigned*)(lds + (bufoff) + ldsw + _i * 8192), 16, 0, 0); } while (0)
#define PG8_LDA(dst, b, h) do { _Pragma("unroll") for (int m = 0; m < 4; ++m) _Pragma("unroll") for (int k = 0; k < 2; ++k) dst[m][k] = *(const PG8_LAS bf16x8*)(lds + PG8_SA(b, h) + aoff + m * 2048 + k * 1024); } while (0)
#define PG8_LDB(dst, b, h) do { _Pragma("unroll") for (int n = 0; n < 2; ++n) _Pragma("unroll") for (int k = 0; k < 2; ++k) dst[n][k] = *(const PG8_LAS bf16x8*)(lds + PG8_SB(b, h) + boff + n * 2048 + k * 1024); } while (0)
#define PG8_MMA(ai, bj, At, Bt) do { __builtin_amdgcn_s_setprio(1); _Pragma("unroll") for (int m = 0; m < 4; ++m) _Pragma("unroll") for (int n = 0; n < 2; ++n) _Pragma("unroll") for (int k = 0; k < 2; ++k) \
        acc[ai][bj][m][n] = __builtin_amdgcn_mfma_f32_16x16x32_bf16(Bt[n][k], At[m][k], acc[ai][bj][m][n], 0, 0, 0); __builtin_amdgcn_s_setprio(0); } while (0)
#define PG8_WAIT_V(n) asm volatile("s_waitcnt vmcnt(" #n ")" ::: "memory")
#define PG8_WAIT_L(n) asm volatile("s_waitcnt lgkmcnt(" #n ")" ::: "memory")
#define PG8_BAR __builtin_amdgcn_s_barrier()
#define PG8_SCHED __builtin_amdgcn_sched_barrier(0)
    Unit cur, nxt; int ui = 0;
    if (!S.next(0, cur)) return;
    f32x4 acc[2][2][4][2];
#pragma unroll
    for (int a = 0; a < 2; ++a)
#pragma unroll
        for (int b = 0; b < 2; ++b)
#pragma unroll
            for (int m = 0; m < 4; ++m)
#pragma unroll
                for (int n = 0; n < 2; ++n) acc[a][b][m][n] = (f32x4){0.f, 0.f, 0.f, 0.f};
    bf16x8 At[4][2], B0[2][2], B1[2][2];
    const char* cA = S.a_base(g, cur); const char* cB = S.b_base(g, cur);
    S.a_ready(cur);
    S.voff_a(g, cur, RA, CA, cvA);
    if constexpr (SP2) {
        PG8_STAGE(PG8_SB(0, 0), cB, voffB); PG8_STAGE(PG8_SB(0, 1), cB + hstep, voffB); PG8_STAGE(PG8_SA(0, 0), cA, cvA[0]); PG8_STAGE(PG8_SA(0, 1), cA, cvA[1]);
        if (wr == 1) PG8_BAR;
        PG8_WAIT_V(2); PG8_BAR;
        PG8_STAGE(PG8_SB(1, 0), cB + kstep, voffB); PG8_STAGE(PG8_SA(1, 0), cA + kstep, cvA[0]); PG8_STAGE(PG8_SB(1, 1), cB + hstep + kstep, voffB);
        PG8_WAIT_V(6); PG8_BAR;
    } else {
        PG8_STAGE(PG8_SB(0, 0), cB, voffB); PG8_STAGE(PG8_SA(0, 0), cA, cvA[0]); PG8_STAGE(PG8_SB(0, 1), cB + hstep, voffB); PG8_STAGE(PG8_SA(0, 1), cA, cvA[1]);
        if (wr == 1) PG8_BAR;
        PG8_WAIT_V(4); PG8_BAR;
        PG8_STAGE(PG8_SB(1, 0), cB + kstep, voffB); PG8_STAGE(PG8_SA(1, 0), cA + kstep, cvA[0]); PG8_STAGE(PG8_SB(1, 1), cB + hstep + kstep, voffB);
        PG8_WAIT_V(6); PG8_BAR;
    }
    for (;;) {
        const bool has_next = S.next(ui + 1, nxt);
        const char* nA = has_next ? S.a_base(g, nxt) : cA; const char* nB = has_next ? S.b_base(g, nxt) : cB;
        if (has_next) S.voff_a(g, nxt, RA, CA, nvA); else { nvA[0][0] = cvA[0][0]; nvA[0][1] = cvA[0][1]; nvA[1][0] = cvA[1][0]; nvA[1][1] = cvA[1][1]; }
        for (int t = 0; t < nt; t += 2) {
            const bool last = (t == nt - 2);
            const char* a1 = cA + (size_t)(t + 1) * kstep;
            const char* a2 = last ? nA : cA + (size_t)(t + 2) * kstep; const char* b2 = last ? nB : cB + (size_t)(t + 2) * kstep;
            const char* a3 = a2 + kstep; const char* b3 = b2 + kstep;
            unsigned xA0[2], xA1[2];
            xA0[0] = last ? nvA[0][0] : cvA[0][0]; xA0[1] = last ? nvA[0][1] : cvA[0][1]; xA1[0] = last ? nvA[1][0] : cvA[1][0]; xA1[1] = last ? nvA[1][1] : cvA[1][1];
            if (last && has_next) S.a_ready(nxt);
            if constexpr (SP2) {
            PG8_LDB(B0, 0, 0); PG8_LDB(B1, 0, 1); PG8_SCHED; PG8_LDA(At, 0, 0); PG8_STAGE(PG8_SA(1, 1), a1, cvA[1]);
            PG8_WAIT_V(8); PG8_WAIT_L(0); PG8_BAR; PG8_MMA(0, 0, At, B0); PG8_MMA(0, 1, At, B1); PG8_BAR; PG8_SCHED;
            PG8_LDA(At, 0, 1); PG8_STAGE(PG8_SB(0, 0), b2, voffB); PG8_STAGE(PG8_SB(0, 1), b2 + hstep, voffB); PG8_STAGE(PG8_SA(0, 0), a2, xA0);
            PG8_WAIT_V(8); PG8_WAIT_L(0); PG8_BAR; PG8_MMA(1, 0, At, B0); PG8_MMA(1, 1, At, B1); PG8_BAR; PG8_SCHED;
            PG8_LDB(B0, 1, 0); PG8_LDB(B1, 1, 1); PG8_SCHED; PG8_LDA(At, 1, 0); PG8_STAGE(PG8_SA(0, 1), a2, xA1);
            PG8_WAIT_V(8); PG8_WAIT_L(0); PG8_BAR; PG8_MMA(0, 0, At, B0); PG8_MMA(0, 1, At, B1); PG8_BAR; PG8_SCHED;
            PG8_LDA(At, 1, 1); PG8_STAGE(PG8_SB(1, 0), b3, voffB); PG8_STAGE(PG8_SB(1, 1), b3 + hstep, voffB); PG8_STAGE(PG8_SA(1, 0), a3, xA0);
            PG8_WAIT_V(8); PG8_WAIT_L(0); PG8_BAR; PG8_MMA(1, 0, At, B0); PG8_MMA(1, 1, At, B1); PG8_BAR; PG8_SCHED;
            } else {
            PG8_LDB(B0, 0, 0); PG8_SCHED; PG8_LDA(At, 0, 0); PG8_STAGE(PG8_SA(1, 1), a1, cvA[1]);
            PG8_WAIT_L(8); PG8_BAR; PG8_WAIT_L(0); PG8_MMA(0, 0, At, B0); PG8_BAR; PG8_SCHED;
            PG8_LDB(B1, 0, 1); PG8_STAGE(PG8_SB(0, 0), b2, voffB);
            PG8_BAR; PG8_WAIT_L(0); PG8_MMA(0, 1, At, B1); PG8_BAR;
            PG8_LDA(At, 0, 1); PG8_STAGE(PG8_SA(0, 0), a2, xA0);
            PG8_BAR; PG8_WAIT_L(0); PG8_MMA(1, 0, At, B0); PG8_BAR; PG8_SCHED;
            PG8_STAGE(PG8_SB(0, 1), b2 + hstep, voffB);
            PG8_WAIT_V(6); PG8_BAR; PG8_MMA(1, 1, At, B1); PG8_BAR;
            PG8_LDB(B0, 1, 0); PG8_SCHED; PG8_LDA(At, 1, 0); PG8_STAGE(PG8_SA(0, 1), a2, xA1);
            PG8_WAIT_L(8); PG8_BAR; PG8_WAIT_L(0); PG8_MMA(0, 0, At, B0); PG8_BAR; PG8_SCHED;
            PG8_LDB(B1, 1, 1); PG8_STAGE(PG8_SB(1, 0), b3, voffB);
            PG8_BAR; PG8_WAIT_L(0); PG8_MMA(0, 1, At, B1); PG8_BAR;
            PG8_LDA(At, 1, 1); PG8_STAGE(PG8_SA(1, 0), a3, xA0);
            PG8_BAR; PG8_WAIT_L(0); PG8_MMA(1, 0, At, B0); PG8_BAR; PG8_SCHED;
            PG8_STAGE(PG8_SB(1, 1), b3 + hstep, voffB);
            PG8_WAIT_V(6); PG8_BAR; PG8_MMA(1, 1, At, B1); PG8_BAR;
            }
        }
        if constexpr (ALIGN_EPI) { if (wr == 0) PG8_BAR; }
        if constexpr (!Epi::AFTER_DRAIN) { E(acc, cur, wr, wc, fr, fq); S.done(cur); }
        if (!has_next) break;
#pragma unroll
        for (int a = 0; a < 2; ++a)
#pragma unroll
            for (int b = 0; b < 2; ++b)
#pragma unroll
                for (int m = 0; m < 4; ++m)
#pragma unroll
                    for (int n = 0; n < 2; ++n) acc[a][b][m][n] = (f32x4){0.f, 0.f, 0.f, 0.f};
        cur = nxt; cA = nA; cB = nB; ++ui; cvA[0][0] = nvA[0][0]; cvA[0][1] = nvA[0][1]; cvA[1][0] = nvA[1][0]; cvA[1][1] = nvA[1][1];
        if constexpr (ALIGN_EPI) { if (wr == 1) PG8_BAR; }
    }
    PG8_WAIT_V(0);
    if constexpr (!ALIGN_EPI) { if (wr == 0) PG8_BAR; }
    PG8_BAR;
    if constexpr (Epi::AFTER_DRAIN) { E.fused(acc, cur, wr, wc, fr, fq, lds, wid, lane); S.done(cur); }
#undef PG8_SA
#undef PG8_SB
#undef PG8_STAGE
#undef PG8_LDA
#undef PG8_LDB
#undef PG8_MMA
#undef PG8_WAIT_V
#undef PG8_WAIT_L
#undef PG8_BAR
#undef PG8_SCHED
}
}

constexpr int NWAVES = 8;
constexpr int BATCH = 2, SEQ = 8192, D = 1024, M = BATCH * SEQ;
constexpr int PROJW = 3096, NPROJ = 3072;
constexpr int FH = 8, GH = 4, NE = 32, TOPK = 4, ECAP = M, NSLOT = M * TOPK + NE * 256;
constexpr float LOG2E = 1.4426950408889634f, C2 = 0.125f * 1.4426950408889634f, EPS = 1e-5f;
constexpr size_t MiB = 1u << 20;
constexpr size_t WS_CTL = 0, CTL_ZERO_BYTES = 1 * MiB;
constexpr size_t WS_TOKL = 2 * MiB;
constexpr size_t WS_PIDX = 4 * MiB, WS_EIDX = WS_PIDX + 256 * 1024, WS_GATE = WS_EIDX + 256 * 1024;
constexpr size_t WS_FLT = 5 * MiB, WS_F2 = WS_FLT + 512 * 1024;
constexpr size_t WS_GLOW = 6 * MiB;
constexpr size_t WS_DECAY = 7 * MiB;
constexpr size_t WS_WIN = 8 * MiB, WS_WOUT = 14 * MiB, WS_E1 = 16 * MiB, WS_E2 = 144 * MiB;
constexpr size_t WS_XN = 208 * MiB;
constexpr size_t WS_P1 = 240 * MiB;
constexpr size_t WS_UPD = 336 * MiB;
constexpr size_t WS_CAT = 368 * MiB;
constexpr size_t WS_H = 400 * MiB;
constexpr size_t WS_ACT = 464 * MiB, WS_Y = 608 * MiB, WS_END = 752 * MiB;
static_assert((size_t)NSLOT * D * 2 <= 144 * MiB, "slot buffers");
constexpr int CW_TMO = 0, CW_CODE = 1, CW_BAR = 4096, CW_ECNT = 8192;
constexpr int CW_QKN = 12288, CW_QUEUE = 16384;
constexpr size_t WS_UTAB = 7 * MiB + 512 * 1024;
constexpr int RING_OFF = 0, RING_BYTES = 131072, EXTRA_OFF = RING_BYTES, EXTRA_BYTES = 28672, LDSCTL_OFF = EXTRA_OFF + EXTRA_BYTES, MISC_OFF = LDSCTL_OFF + 320, LDS_BYTES = 163840;
static_assert(MISC_OFF + 128 <= LDS_BYTES, "LDS map");

#define GAS __attribute__((address_space(1)))
#define LAS __attribute__((address_space(3)))
typedef unsigned short bf16;
typedef unsigned v4u __attribute__((ext_vector_type(4)));
typedef float f32x4 __attribute__((ext_vector_type(4)));
typedef short bf16x8 __attribute__((ext_vector_type(8)));
typedef GAS unsigned gu32;
typedef GAS unsigned long long gu64;
#define RLX_AGENT __ATOMIC_RELAXED, __HIP_MEMORY_SCOPE_AGENT
#define LDS_WAIT() asm volatile("s_waitcnt lgkmcnt(0)" ::: "memory")
#define VM_WAIT() asm volatile("s_waitcnt vmcnt(0)" ::: "memory")
__device__ __forceinline__ unsigned long long rt() { return __builtin_amdgcn_s_memrealtime(); }
__device__ __forceinline__ unsigned f2bf(float f) { unsigned u = __builtin_bit_cast(unsigned, f); return (u + 0x7fffu + ((u >> 16) & 1u)) >> 16; }
__device__ __forceinline__ unsigned pk2(float lo, float hi) { return f2bf(lo) | (f2bf(hi) << 16); }

#define XB_TMO      128
#define XB_XCNT(j)  (256  + 64 * (j))
#define XB_XSUB(j)  (1280 + 64 * (j))
#define XB_XGEN(j)  (2304 + 64 * (j))
#define XB_TOP      3328
#define XB_TOPGEN   3392
#define XCD_BAR_WORDS 3456
#define XB_SPIN_CAP (1u << 18)

__device__ __forceinline__ unsigned xb_ld(unsigned* p)              { return __hip_atomic_load(p, __ATOMIC_RELAXED, __HIP_MEMORY_SCOPE_AGENT); }
__device__ __forceinline__ unsigned xb_add(unsigned* p, unsigned v) { return __hip_atomic_fetch_add(p, v, __ATOMIC_RELAXED, __HIP_MEMORY_SCOPE_AGENT); }
__device__ __forceinline__ unsigned xb_xcc_id() { return (unsigned)__builtin_amdgcn_s_getreg((3 << 11) | 20) & 0xFu; }
#define XB_SPIN(cond, bar) do { unsigned _sp = 0; while (cond) { __builtin_amdgcn_s_sleep(1); \
    if ((++_sp & 255u) == 0u) { if (xb_ld(&(bar)[XB_TMO])) break; if (_sp > XB_SPIN_CAP) { atomicAdd(&(bar)[XB_TMO], 1u); break; } } } } while (0)

struct XcdBarrier {
    unsigned* bar; unsigned x;
    volatile LAS unsigned* st;
};

__device__ __forceinline__ XcdBarrier xcd_barrier_post(unsigned* bar, volatile LAS unsigned* st) {
    XcdBarrier b; b.bar = bar; b.x = xb_xcc_id(); b.st = st;
    if (threadIdx.x == 0) (void)xb_add(&bar[XB_XCNT(b.x)], 1u);
    return b;
}
__device__ __forceinline__ void xcd_barrier_complete(unsigned* bar, unsigned x, unsigned& nloc, unsigned& nx) {
    const unsigned G = gridDim.x * gridDim.y * gridDim.z;
    unsigned sum, cnt, mine, sp = 0u;
    for (;;) {
        sum = 0u; cnt = 0u; mine = 0u;
#pragma unroll
        for (unsigned j = 0; j < 16; ++j) { const unsigned c = xb_ld(&bar[XB_XCNT(j)]); sum += c; cnt += (c > 0u) ? 1u : 0u; mine = (j == x) ? c : mine; }
        if (sum == G) break;
        __builtin_amdgcn_s_sleep(1);
        if ((++sp & 255u) == 0u) { if (xb_ld(&bar[XB_TMO])) break; if (sp > XB_SPIN_CAP) { atomicAdd(&bar[XB_TMO], 1u); break; } }
    }
    nloc = mine > 0u ? mine : 1u; nx = cnt > 0u ? cnt : 1u;
}

__device__ __forceinline__ void xcd_barrier(const XcdBarrier& b) {
    asm volatile("s_waitcnt vmcnt(0)" ::: "memory");
    __syncthreads();
    if (threadIdx.x == 0) {
        unsigned* bar = b.bar;
        __builtin_amdgcn_s_waitcnt(0);
        unsigned nloc = b.st[0], nx = b.st[1];
        if (nloc == 0u) { xcd_barrier_complete(bar, b.x, nloc, nx); b.st[0] = nloc; b.st[1] = nx; }
        const unsigned old = xb_add(&bar[XB_XSUB(b.x)], 1u);
        const unsigned gen = old / nloc;
        if (old + 1u == (gen + 1u) * nloc) {
            __builtin_amdgcn_fence(__ATOMIC_RELEASE, "agent");
            asm volatile("s_waitcnt vmcnt(0)" ::: "memory");
            const unsigned og = xb_add(&bar[XB_TOP], 1u);
            const unsigned tg = og / nx;
            if (og + 1u == (tg + 1u) * nx) xb_add(&bar[XB_TOPGEN], 1u);
            else XB_SPIN(xb_ld(&bar[XB_TOPGEN]) == tg, bar);
            __builtin_amdgcn_fence(__ATOMIC_ACQUIRE, "agent");
            xb_add(&bar[XB_XGEN(b.x)], 1u);
            asm volatile("s_waitcnt vmcnt(0)" ::: "memory");
        } else {
            XB_SPIN(xb_ld(&bar[XB_XGEN(b.x)]) == gen, bar);
            __builtin_amdgcn_fence(__ATOMIC_ACQUIRE, "agent");
            asm volatile("s_waitcnt vmcnt(0)" ::: "memory");
        }
    }
    __syncthreads();
}

struct Frame {
    LAS unsigned char* lds; volatile LAS unsigned* MISC; gu32* ctl;
    int tid, lane, wave, vcu, G;
    const float *x, *n1g, *w_in, *fbias, *gup, *gbias, *gng, *w_out, *n2g, *rw, *rb, *ewi, *ebi, *ewo, *ebo, *fg; float* out; unsigned char* ws;
};
__device__ __forceinline__ float wave_sum(float v) {
#pragma unroll
    for (int o = 1; o < 64; o <<= 1) v += __shfl_xor(v, o);
    return v;
}
__device__ __forceinline__ float log_sigmoid_f(float x) { return fminf(x, 0.f) - log1pf(__expf(-fabsf(x))); }
#define BFLY_STEP(n, m) { const bool up_ = (lane & (m)) != 0; _Pragma("unroll") for (int i_ = 0; i_ < (n) / 2; ++i_) { const float send_ = up_ ? v[i_] : v[i_ + (n) / 2]; const float recv_ = __shfl_xor(send_, (m)); \
        const float keep_ = up_ ? v[i_ + (n) / 2] : v[i_]; v[i_] = keep_ + recv_; } }
__device__ __forceinline__ float bfly32(float (&v)[32], int lane) { BFLY_STEP(32, 32) BFLY_STEP(16, 16) BFLY_STEP(8, 8) BFLY_STEP(4, 4) BFLY_STEP(2, 2) return v[0] + __shfl_xor(v[0], 1); }

__device__ __forceinline__ void p0_transpose_blk(const float* W, int ld, int k0, int c0, bf16* WT, int K, int r0, LAS float* scr, int lane) {
#pragma unroll 8
    for (int i = 0; i < 32; ++i) { const int kk = 2 * i + (lane >> 5); scr[kk * 33 + (lane & 31)] = W[(size_t)(k0 + kk) * ld + c0 + (lane & 31)]; }
    LDS_WAIT(); asm volatile("" ::: "memory");
    const int c = lane & 7;
#pragma unroll
    for (int j = 0; j < 4; ++j) { const int n = (lane >> 3) + 8 * j; const LAS float* s = scr + (8 * c) * 33 + n;
        v4u o; o.x = pk2(s[0 * 33], s[1 * 33]); o.y = pk2(s[2 * 33], s[3 * 33]); o.z = pk2(s[4 * 33], s[5 * 33]); o.w = pk2(s[6 * 33], s[7 * 33]);
        *(GAS v4u*)(WT + (size_t)(r0 + n) * K + k0 + 8 * c) = o; }
    LDS_WAIT(); asm volatile("" ::: "memory");
}
constexpr int W24_LD = 1032;
__device__ __forceinline__ void p0_row(Frame& F, int m, const LAS float* w24, const f32x4 (&gv)[4], bf16* XN, float* FLT, float* GLOW) {
    int lane = F.lane; asm volatile("" : "+v"(lane));
    const GAS f32x4* xr = (const GAS f32x4*)(F.x + (size_t)m * D) + lane;
    f32x4 v[4]; float s = 0.f;
#pragma unroll
    for (int j = 0; j < 4; ++j) { v[j] = xr[64 * j]; s += (v[j].x * v[j].x + v[j].y * v[j].y) + (v[j].z * v[j].z + v[j].w * v[j].w); }
    const float rstd = 1.f / sqrtf(wave_sum(s) * (1.f / D) + EPS);
    GAS unsigned long long* o8 = (GAS unsigned long long*)(XN + (size_t)m * D) + lane;
#pragma unroll
    for (int j = 0; j < 4; ++j) { v[j] = v[j] * rstd * gv[j]; o8[64 * j] = (unsigned long long)pk2(v[j].x, v[j].y) | ((unsigned long long)pk2(v[j].z, v[j].w) << 32); }
    float a[32];
#pragma unroll
    for (int c = 0; c < 24; ++c) { float t = 0.f;
#pragma unroll
        for (int j = 0; j < 4; ++j) { const f32x4 w = *(const LAS f32x4*)(w24 + c * W24_LD + 256 * j + 4 * lane); t += (v[j].x * w.x + v[j].y * w.y) + (v[j].z * w.z + v[j].w * w.w); }
        a[c] = t; if ((c & 3) == 3) asm volatile("" ::: "memory"); }
#pragma unroll
    for (int c = 24; c < 32; ++c) a[c] = 0.f;
    const float tot = bfly32(a, lane);
    const int idx = lane >> 1;
    if ((lane & 1) == 0) {
        if (idx < 8) FLT[(size_t)idx * M + m] = log_sigmoid_f(tot + F.fbias[idx]) * LOG2E;
        else if (idx < 24) GLOW[(size_t)m * 16 + (idx - 8)] = tot;
    }
}
__device__ __forceinline__ void p0_prologue(Frame& F) {
    const int gw = F.vcu * NWAVES + F.wave, NGW = F.G * NWAVES, tid = F.tid;
    bf16* XN = (bf16*)(F.ws + WS_XN); float* FLT = (float*)(F.ws + WS_FLT); float* GLOW = (float*)(F.ws + WS_GLOW);
    LAS float* w24 = (LAS float*)(F.lds + RING_OFF);
    __syncthreads();
    for (int it = 0; it < 16; ++it) { const int i = tid + 512 * it, k = i >> 3, c = i & 7; w24[c * W24_LD + k] = F.w_in[(size_t)k * PROJW + 1536 + c]; }
    for (int it = 0; it < 32; ++it) { const int i = tid + 512 * it, k = i >> 4, c = i & 15; w24[(8 + c) * W24_LD + k] = F.w_in[(size_t)k * PROJW + 2568 + c]; }
    __syncthreads();
    { f32x4 gv[4]; int lane_ = F.lane; asm volatile("" : "+v"(lane_));
#pragma unroll
      for (int j = 0; j < 4; ++j) gv[j] = ((const GAS f32x4*)F.n1g)[lane_ + 64 * j];
      for (int m = gw; m < M; m += NGW) p0_row(F, m, w24, gv, XN, FLT, GLOW); }
    __syncthreads();
    LAS float* scr = (LAS float*)(F.lds + RING_OFF + F.wave * 16384);
    bf16* WIN = (bf16*)(F.ws + WS_WIN); bf16* WOUT = (bf16*)(F.ws + WS_WOUT);
    constexpr int I_IN = 16 * 96, I_OUT = 16 * 32, NITEMS = I_IN + I_OUT;
    for (int it = gw; it < NITEMS; it += NGW) {
        int r = it;
        if (r < I_IN) { const int kb = r / 96, nb = r % 96, r0 = 32 * nb, c0 = r0 + (r0 < 1536 ? 0 : (r0 < 2560 ? 8 : 24)); p0_transpose_blk(F.w_in, PROJW, 64 * kb, c0, WIN, D, r0, scr, F.lane); continue; } r -= I_IN;
        { const int kb = r / 32, nb = r % 32; p0_transpose_blk(F.w_out, D, 64 * kb, 32 * nb, WOUT, D, 32 * nb, scr, F.lane); }
    }
}
constexpr int CONV_I_E1 = 16 * 64, CONV_I_E2 = 16 * 32, CONV_BATCHES = NE * (CONV_I_E1 + CONV_I_E2) / 32;
struct ConvBlk { const float* src; bf16* dst; int ld; };
__device__ __forceinline__ ConvBlk conv_blk(Frame& F, int r) {
    ConvBlk b;
    if (r < NE * CONV_I_E1) { const int e = r / CONV_I_E1, q = r % CONV_I_E1, kb = q / 64, nb = q % 64, r0 = 32 * nb, within = r0 & 255, c0 = (within >> 7) * 1024 + (r0 >> 8) * 128 + (within & 127);
        b.src = F.ewi + (size_t)e * D * 2048 + (size_t)(64 * kb) * 2048 + c0; b.dst = (bf16*)(F.ws + WS_E1) + (size_t)e * 2048 * D + (size_t)r0 * D + 64 * kb; b.ld = 2048; }
    else { r -= NE * CONV_I_E1; const int e = r / CONV_I_E2, q = r % CONV_I_E2, kb = q / 32, nb = q % 32;
        b.src = F.ewo + (size_t)e * D * D + (size_t)(64 * kb) * D + 32 * nb; b.dst = (bf16*)(F.ws + WS_E2) + (size_t)e * D * D + (size_t)(32 * nb) * D + 64 * kb; b.ld = D; }
    return b;
}
__device__ __forceinline__ void conv_load(const ConvBlk& b, int lane, f32x4 (&v)[8]) {
#pragma unroll
    for (int i = 0; i < 8; ++i) v[i] = __builtin_nontemporal_load((const f32x4*)(b.src + (size_t)(8 * i + (lane >> 3)) * b.ld + 4 * (lane & 7)));
}
__device__ __forceinline__ void conv_batch(Frame& F, int batch) {
    LAS float* scr = (LAS float*)(F.lds + RING_OFF + F.wave * 16384); const int lane = F.lane;
    f32x4 v[8]; ConvBlk cur = conv_blk(F, batch * 32 + F.wave * 4);
    conv_load(cur, lane, v);
#pragma unroll 1
    for (int j = 0; j < 4; ++j) {
#pragma unroll
        for (int i = 0; i < 8; ++i) *(LAS f32x4*)(scr + (8 * i + (lane >> 3)) * 32 + 4 * (((lane & 7) + i) & 7)) = v[i];
        const ConvBlk nxt = conv_blk(F, batch * 32 + F.wave * 4 + (j < 3 ? j + 1 : j));
        if (j < 3) conv_load(nxt, lane, v);
        LDS_WAIT(); asm volatile("" ::: "memory");
        const int c = lane & 7;
#pragma unroll
        for (int jj = 0; jj < 4; ++jj) { const int n = (lane >> 3) + 8 * jj; const LAS float* sp = scr + (8 * c) * 32 + 4 * (((n >> 2) + c) & 7) + (n & 3);
            v4u o; o.x = pk2(sp[0 * 32], sp[1 * 32]); o.y = pk2(sp[2 * 32], sp[3 * 32]); o.z = pk2(sp[4 * 32], sp[5 * 32]); o.w = pk2(sp[6 * 32], sp[7 * 32]);
            *(GAS v4u*)(cur.dst + (size_t)n * D + 8 * c) = o; }
        LDS_WAIT(); asm volatile("" ::: "memory");
        cur = nxt;
    }
    __syncthreads();
}

#include <hip/hip_bf16.h>
#include <cmath>
namespace attn_body {
using bf16=__hip_bfloat16;
using bf16x8=__attribute__((ext_vector_type(8)))short;
using s16x4=__attribute__((ext_vector_type(4)))short;
using f32x16=__attribute__((ext_vector_type(16)))float;
using u32x4=__attribute__((ext_vector_type(4)))unsigned;
constexpr int BATCH=2,NHEAD=8,SEQ=8192,D=64,DM=NHEAD*D,OPITCH=1024;
constexpr int NW=8,QBLK=32,QB=QBLK*NW,KVBLK=64,NQB=SEQ/QB;
constexpr int ATTN_PITCH=DM, ATTN_UNIT_ROWS=QB;
__device__ __forceinline__ int crow(int r,int hi){return (r&3)+8*(r>>2)+4*hi;}
#define SBAR() __builtin_amdgcn_sched_barrier(0)
__device__ __forceinline__ void cmask(f32x16&p0,f32x16&p1,int jb,int qrel,int hi){
  const float NEG=-INFINITY; int kb=64*jb+4*hi;
  #pragma unroll
  for(int r=0;r<16;++r){int kv=kb+(r&3)+8*(r>>2); if(kv>qrel)p0[r]=NEG; if(kv+32>qrel)p1[r]=NEG;}
}

constexpr int NSLOT=3, SLOTB=8192;
constexpr int LDS_K=0, LDS_V=NSLOT*SLOTB, LDS_WS=2*NSLOT*SLOTB, LDS_OST=LDS_WS+NW*64*4, LDS_F=LDS_OST+NW*4096, LDS_BYTES=LDS_F+SEQ*4;
constexpr float C2=0.125f*1.4426950408889634f;
__device__ __forceinline__ void glds16(const void*gsrc,unsigned lds_dst){unsigned keep;
  asm volatile("s_mov_b32 %0, m0\n\ts_mov_b32 m0, %2\n\ts_nop 0\n\tglobal_load_lds_dwordx4 %1, off\n\ts_mov_b32 m0, %0":"=&s"(keep):"v"(gsrc),"s"(lds_dst):"memory");}
__device__ __forceinline__ float max3f(float a,float b,float c){float r;asm("v_max3_f32 %0, %1, %2, %3":"=v"(r):"v"(a),"v"(b),"v"(c));return r;}
__device__ __forceinline__ float max2f(float a,float b){float r;asm("v_max_f32_e32 %0, %1, %2":"=v"(r):"v"(a),"v"(b));return r;}
__device__ __forceinline__ float fadd_s(float a,float b){float r;asm("v_add_f32_e32 %0, %1, %2":"=v"(r):"v"(a),"v"(b));return r;}
__device__ __forceinline__ float fsub_s(float a,float b){float r;asm("v_sub_f32_e32 %0, %1, %2":"=v"(r):"v"(a),"v"(b));return r;}
typedef float f32x2_t __attribute__((ext_vector_type(2))); typedef __bf16 bf16x2_t __attribute__((ext_vector_type(2)));
__device__ __forceinline__ unsigned cvtpk_s(float lo,float hi){f32x2_t v={lo,hi};bf16x2_t b=__builtin_convertvector(v,bf16x2_t);return __builtin_bit_cast(unsigned,b);}
#define WAIT_BAR(N) asm volatile("s_waitcnt vmcnt(" #N ") lgkmcnt(0)\n\ts_barrier":::"memory")

__device__ __forceinline__ void qkt(f32x16&p0,f32x16&p1,const char*Kslot,const bf16x8*qr,int r32,int hi){
  const char*kb=Kslot+hi*1024+r32*16;
  #pragma unroll
  for(int d0=0;d0<4;++d0){
    const bf16x8 b0=*reinterpret_cast<const bf16x8*>(kb+d0*2048);
    const bf16x8 b1=*reinterpret_cast<const bf16x8*>(kb+d0*2048+512);
    p0=__builtin_amdgcn_mfma_f32_32x32x16_bf16(b0,qr[d0],p0,0,0,0);p1=__builtin_amdgcn_mfma_f32_32x32x16_bf16(b1,qr[d0],p1,0,0,0);}
}
typedef __attribute__((address_space(3))) const char* lds_cptr;
typedef short v4i16_t __attribute__((ext_vector_type(4)));
__device__ __forceinline__ void kload8(bf16x8*kf,lds_cptr kp){
  kf[0]=*(const __attribute__((address_space(3))) bf16x8*)(kp);      kf[1]=*(const __attribute__((address_space(3))) bf16x8*)(kp+512);
  kf[2]=*(const __attribute__((address_space(3))) bf16x8*)(kp+2048); kf[3]=*(const __attribute__((address_space(3))) bf16x8*)(kp+2560);
  kf[4]=*(const __attribute__((address_space(3))) bf16x8*)(kp+4096); kf[5]=*(const __attribute__((address_space(3))) bf16x8*)(kp+4608);
  kf[6]=*(const __attribute__((address_space(3))) bf16x8*)(kp+6144); kf[7]=*(const __attribute__((address_space(3))) bf16x8*)(kp+6656);
}
__device__ __forceinline__ void kload2(bf16x8*kf,lds_cptr kp,int j){ kf[2*j]=*(const __attribute__((address_space(3))) bf16x8*)(kp+j*2048); kf[2*j+1]=*(const __attribute__((address_space(3))) bf16x8*)(kp+j*2048+512); }
typedef float f32x4_t __attribute__((ext_vector_type(4)));
__device__ __forceinline__ void fkinit(f32x16&c0,f32x16&c1,lds_cptr fp,float qoff){
  #pragma unroll
  for(int g=0;g<4;++g){ const f32x4_t a=*(const __attribute__((address_space(3))) f32x4_t*)(fp+g*32); const f32x4_t b=*(const __attribute__((address_space(3))) f32x4_t*)(fp+128+g*32);
    #pragma unroll
    for(int i=0;i<4;++i){ c0[4*g+i]=qoff-a[i]; c1[4*g+i]=qoff-b[i]; } }
}
__device__ __forceinline__ s16x4 vtr(lds_cptr p){ return __builtin_bit_cast(s16x4,__builtin_amdgcn_ds_read_tr16_b64_v4i16((__attribute__((address_space(3))) v4i16_t*)p)); }
__device__ __forceinline__ float rowmax(const f32x16&p0,const f32x16&p1){
  float a=max3f(p0[0],p0[1],p1[0]),b=max3f(p0[2],p0[3],p1[1]);a=max3f(a,p1[2],p1[3]);
  #pragma unroll
  for(int r=4;r<16;r+=4){a=max3f(a,p0[r],p0[r+1]);b=max3f(b,p0[r+2],p0[r+3]);a=max3f(a,p1[r],p1[r+1]);b=max3f(b,p1[r+2],p1[r+3]);}
  const float m=max2f(a,b);
  auto rr=__builtin_amdgcn_permlane32_swap(__float_as_uint(m),__float_as_uint(m),false,false);
  return max2f(__uint_as_float(rr[0]),__uint_as_float(rr[1]));
}
__device__ __forceinline__ void pv(f32x16*o,int vb,bf16x8 pa0,bf16x8 pa1,bf16x8 pa2,bf16x8 pa3){
  #pragma unroll
  for(int d0=0;d0<2;++d0){s16x4 lo[4],hi[4];
    #pragma unroll
    for(int ks=0;ks<4;++ks){
      asm volatile("ds_read_b64_tr_b16 %0,%1 offset:%c2":"=&v"(lo[ks]):"v"(vb),"i"(d0*4096+ks*1024):"memory");
      asm volatile("ds_read_b64_tr_b16 %0,%1 offset:%c2":"=&v"(hi[ks]):"v"(vb),"i"(d0*4096+ks*1024+512):"memory");}
    asm volatile("s_waitcnt lgkmcnt(0)":::"memory");SBAR();
    #define PK(k) (bf16x8){lo[k][0],lo[k][1],lo[k][2],lo[k][3],hi[k][0],hi[k][1],hi[k][2],hi[k][3]}
    o[d0]=__builtin_amdgcn_mfma_f32_32x32x16_bf16(pa0,PK(0),o[d0],0,0,0);
    o[d0]=__builtin_amdgcn_mfma_f32_32x32x16_bf16(pa1,PK(1),o[d0],0,0,0);
    o[d0]=__builtin_amdgcn_mfma_f32_32x32x16_bf16(pa2,PK(2),o[d0],0,0,0);
    o[d0]=__builtin_amdgcn_mfma_f32_32x32x16_bf16(pa3,PK(3),o[d0],0,0,0);
    #undef PK
  }
}

#ifndef ATTN_STORE16
#define ATTN_STORE16(p,v) (*(u32x4*)(p)=(v))
#endif
template<int THRL> __device__ __forceinline__ void attn_unit(int b,int h,int qb,int T0,const bf16*Q,const bf16*__restrict__ K,const bf16*__restrict__ V,const float*__restrict__ F2,bf16*O,char*shm){
  const int tid=threadIdx.x,lane=tid&63,r32=lane&31,hi=lane>>5; const int wid=__builtin_amdgcn_readfirstlane(tid>>6);
  const long rowbase=(long)b*SEQ; const int q0=qb*QB;
  const bf16*Qw=Q+(rowbase+q0+wid*QBLK)*DM+h*D;
  const bf16*Kh=K+(rowbase+(long)T0*KVBLK)*DM+h*D,*Vh=V+(rowbase+(long)T0*KVBLK)*DM+h*D;
  const unsigned lds0=(unsigned)(uintptr_t)shm;
  float*wsf=(float*)(shm+LDS_WS)+wid*64;
  const bf16*ksrc=Kh+(long)lane*DM+wid*8;
  const bf16*vsrc=Vh+(long)(16*(wid&3)+(lane>>2))*DM+(wid>>2)*32+(lane&3)*8;
  const unsigned kdst=lds0+LDS_K+wid*1024, vdst=lds0+LDS_V+wid*1024;
  #define DMA_K(t,slot) glds16(ksrc+(long)(t)*KVBLK*DM,(unsigned)__builtin_amdgcn_readfirstlane(kdst+(slot)))
  #define DMA_V(t,slot) glds16(vsrc+(long)(t)*KVBLK*DM,(unsigned)__builtin_amdgcn_readfirstlane(vdst+(slot)))
  const int vb0=(int)(lds0+LDS_V)+((lane>>4)&1)*32+(lane&3)*8+(4*hi+((lane&15)>>2))*64;
  const char*Kbase=shm+LDS_K; bf16x8 kf[8];
  const lds_cptr shm3=(lds_cptr)shm; const lds_cptr kp0=shm3+LDS_K+hi*1024+r32*16; const lds_cptr vp0=shm3+LDS_V+((lane>>4)&1)*32+(lane&3)*8+(4*hi+((lane&15)>>2))*64;
  const int NT=(q0+QB)/KVBLK-T0;
  const float*F2h=F2+(long)(b*NHEAD+h)*SEQ;
  for(int p_=wid;p_<((NT+3)>>2);p_+=NW) glds16(F2h+T0*KVBLK+p_*256+lane*4,(unsigned)__builtin_amdgcn_readfirstlane(lds0+LDS_F+p_*1024));
  const lds_cptr fp0=shm3+LDS_F+hi*16;
  DMA_K(0,0);DMA_V(0,0);DMA_K(1,SLOTB);
  bf16x8 qr[4];
  #pragma unroll
  for(int d0=0;d0<4;++d0)qr[d0]=*reinterpret_cast<const bf16x8*>(&Qw[(long)r32*DM+d0*16+hi*8]);
  const float F2q=F2h[q0+wid*QBLK+r32]; float mhat=0.f,l_reg=0.f,qoff=F2q;f32x16 o[2];o[0]=f32x16{};o[1]=f32x16{};
  const int qrel=wid*QBLK+r32;
  #define CMASK(P0,P1,t) do{int jb_=(t)-(NT-4); if(jb_>=0)cmask(P0,P1,jb_,qrel,hi);}while(0)
  bool resc=false;
  #define START(P0,P1) do{ const float rm=rowmax(P0,P1); resc=false; \
    { const float dl=rm; mhat=fadd_s(mhat,dl); \
      _Pragma("unroll") for(int r=0;r<16;++r){P0[r]=fsub_s(P0[r],dl);P1[r]=fsub_s(P1[r],dl);} \
      qoff=F2q-mhat; } \
    _Pragma("unroll") for(int r=0;r<16;++r)P0[r]=__builtin_amdgcn_exp2f(P0[r]); }while(0)
  #define RESC() do{ if(resc){ asm volatile("s_waitcnt lgkmcnt(0)":::"memory"); \
      _Pragma("unroll") for(int d_=0;d_<2;++d_) _Pragma("unroll") for(int r=0;r<16;++r)o[d_][r]*=wsf[crow(r,hi)]; } }while(0)
  f32x16 pA0,pA1,pB0,pB1;
  int sl_prev=0,sl_cur=0,sl_next=SLOTB;
  #define ROT() do{sl_prev=sl_cur;sl_cur=sl_next;sl_next=(sl_next==(NSLOT-1)*SLOTB)?0:sl_next+SLOTB;}while(0)
  DMA_K(2,2*SLOTB);
  WAIT_BAR(3);
  fkinit(pA0,pA1,fp0,qoff); qkt(pA0,pA1,Kbase,qr,r32,hi);asm volatile("s_nop 15\n\ts_nop 7":"+v"(pA0),"+v"(pA1));CMASK(pA0,pA1,0);
  START(pA0,pA1);
  _Pragma("unroll") for(int r=0;r<16;++r)pA1[r]=__builtin_amdgcn_exp2f(pA1[r]);
  WAIT_BAR(0);
  DMA_K(3,0);DMA_V(1,SLOTB);
  ROT();
  kload8(kf,kp0+sl_cur);
  WAIT_BAR(2);
  s16x4 vlo[8],vhi[8]; u32x4 pw0,pw1,pw2,pw3;
  #define PKW(P,B) cvtpk_s(P[B],P[B+1])
  #define PAF(k) __builtin_bit_cast(bf16x8,pw##k)
  #define VFR(i) (bf16x8){vlo[i][0],vlo[i][1],vlo[i][2],vlo[i][3],vhi[i][0],vhi[i][1],vhi[i][2],vhi[i][3]}
  #define PIN(x) asm volatile("":"+v"(x))
  #define MX3(a,b,c) __builtin_fmaxf(__builtin_fmaxf((a),(b)),(c))
  #define GAPA(MF,A0,A1,A2,A3,W0,W1,PW) do{ MF; sacc+=A0; sacc+=A1; sacc+=A2; sacc+=A3; PIN(sacc); W0; W1; PIN(PW); SBAR(); }while(0)
  #define EX(v) __builtin_amdgcn_exp2f(v)
  #define GAPB(MF,X,B) do{ MF; X[B]=EX(X[B]); X[B+1]=EX(X[B+1]); X[B+2]=EX(X[B+2]); X[B+3]=EX(X[B+3]); PIN(X); SBAR(); }while(0)
  #define VRD(i) do{ vlo[i]=vtr(vp_+(((i)>>2)*4096+((i)&3)*1024)); vhi[i]=vtr(vp_+(((i)>>2)*4096+((i)&3)*1024+512)); }while(0)
  #define KRD(G,j) do{ if(G){ kload2(kf,kp0+sl_next,j); SBAR(); } }while(0)
  #define STEP(C0,C1,P0,P1,t,GK,GV,GL) do{ SBAR(); \
    fkinit(C0,C1,fp0+(t)*256,qoff); SBAR(); \
    const lds_cptr vp_=vp0+sl_prev; \
    VRD(0); SBAR(); float sacc=(P0[0]+P0[1]); \
    GAPA(C0=__builtin_amdgcn_mfma_f32_32x32x16_bf16(kf[0],qr[0],C0,0,0,0), P0[2],P0[3],P0[4],P0[5],     pw0[0]=PKW(P0,0), pw0[1]=PKW(P0,2), pw0); \
    VRD(4); SBAR(); GAPA(C1=__builtin_amdgcn_mfma_f32_32x32x16_bf16(kf[1],qr[0],C1,0,0,0), P0[6],P0[7],P0[8],P0[9],     pw0[2]=PKW(P0,4), pw0[3]=PKW(P0,6), pw0); \
    VRD(1); SBAR(); GAPA(C0=__builtin_amdgcn_mfma_f32_32x32x16_bf16(kf[2],qr[1],C0,0,0,0),   P0[10],P0[11],P0[12],P0[13], pw1[0]=PKW(P0,8), pw1[1]=PKW(P0,10), pw1); \
    VRD(5); SBAR(); GAPA(C1=__builtin_amdgcn_mfma_f32_32x32x16_bf16(kf[3],qr[1],C1,0,0,0),   P0[14],P0[15],P1[0],P1[1],   pw1[2]=PKW(P0,12),pw1[3]=PKW(P0,14), pw1); \
    VRD(2); SBAR(); GAPA(C0=__builtin_amdgcn_mfma_f32_32x32x16_bf16(kf[4],qr[2],C0,0,0,0),   P1[2],P1[3],P1[4],P1[5],     pw2[0]=PKW(P1,0), pw2[1]=PKW(P1,2), pw2); \
    VRD(6); SBAR(); GAPA(C1=__builtin_amdgcn_mfma_f32_32x32x16_bf16(kf[5],qr[2],C1,0,0,0),   P1[6],P1[7],P1[8],P1[9],     pw2[2]=PKW(P1,4), pw2[3]=PKW(P1,6), pw2); \
    VRD(3); SBAR(); GAPA(C0=__builtin_amdgcn_mfma_f32_32x32x16_bf16(kf[6],qr[3],C0,0,0,0),   P1[10],P1[11],P1[12],P1[13], pw3[0]=PKW(P1,8), pw3[1]=PKW(P1,10), pw3); \
    VRD(7); SBAR(); GAPA(C1=__builtin_amdgcn_mfma_f32_32x32x16_bf16(kf[7],qr[3],C1,0,0,0),   P1[14],P1[15],0.f,0.f,       pw3[2]=PKW(P1,12),pw3[3]=PKW(P1,14), pw3); \
    l_reg+=sacc; \
    if(GK){DMA_K((t)+3,sl_cur);} if(GV){DMA_V((t)+1,sl_next);} \
    CMASK(C0,C1,t); \
    { float a=MX3(C0[0],C0[1],C1[0]),b=MX3(C0[2],C0[3],C1[1]); a=MX3(a,C1[2],C1[3]); \
      _Pragma("unroll") for(int r=4;r<16;r+=4){a=MX3(a,C0[r],C0[r+1]);b=MX3(b,C0[r+2],C0[r+3]);a=MX3(a,C1[r],C1[r+1]);b=MX3(b,C1[r+2],C1[r+3]);} \
      float rm=__builtin_fmaxf(a,b); { auto rr=__builtin_amdgcn_permlane32_swap(__float_as_uint(rm),__float_as_uint(rm),false,false); rm=__builtin_fmaxf(__uint_as_float(rr[0]),__uint_as_float(rr[1])); } \
      resc=false; \
      if(__builtin_expect(__any(rm>(float)THRL),0)){ const float dl=__builtin_fmaxf(rm,0.f); mhat+=dl; \
        _Pragma("unroll") for(int r=0;r<16;++r){C0[r]-=dl;C1[r]-=dl;} \
        qoff=F2q-mhat; \
        const float f=__builtin_amdgcn_exp2f(-dl); l_reg*=f; if(hi==0)wsf[r32]=f; resc=true; } } \
    SBAR(); \
    GAPB(o[0]=__builtin_amdgcn_mfma_f32_32x32x16_bf16(PAF(0),VFR(0),o[0],0,0,0), C0,0); \
    GAPB(o[1]=__builtin_amdgcn_mfma_f32_32x32x16_bf16(PAF(0),VFR(4),o[1],0,0,0), C0,4); \
    KRD(GL,0); GAPB(o[0]=__builtin_amdgcn_mfma_f32_32x32x16_bf16(PAF(1),VFR(1),o[0],0,0,0), C0,8); \
    KRD(GL,1); GAPB(o[1]=__builtin_amdgcn_mfma_f32_32x32x16_bf16(PAF(1),VFR(5),o[1],0,0,0), C0,12); \
    KRD(GL,2); GAPB(o[0]=__builtin_amdgcn_mfma_f32_32x32x16_bf16(PAF(2),VFR(2),o[0],0,0,0), C1,0); \
    KRD(GL,3); GAPB(o[1]=__builtin_amdgcn_mfma_f32_32x32x16_bf16(PAF(2),VFR(6),o[1],0,0,0), C1,4); \
    GAPB(o[0]=__builtin_amdgcn_mfma_f32_32x32x16_bf16(PAF(3),VFR(3),o[0],0,0,0), C1,8); \
    GAPB(o[1]=__builtin_amdgcn_mfma_f32_32x32x16_bf16(PAF(3),VFR(7),o[1],0,0,0), C1,12); \
    }while(0)
  int t=1;
  #undef CMASK
  #define CMASK(P0,P1,t) do{}while(0)
  for(;t+5<NT;t+=2){
    STEP(pB0,pB1,pA0,pA1,t,true,true,true);     WAIT_BAR(2); RESC(); ROT();
    STEP(pA0,pA1,pB0,pB1,t+1,true,true,true);   WAIT_BAR(2); RESC(); ROT();
  }
  #undef CMASK
  #define CMASK(P0,P1,t) do{int jb_=(t)-(NT-4); if(jb_>=0)cmask(P0,P1,jb_,qrel,hi);}while(0)
  #define ENDW(tt) do{ if((tt)+3<NT){WAIT_BAR(2);} else if((tt)+2<NT){WAIT_BAR(1);} else {WAIT_BAR(0);} }while(0)
  for(;t+1<NT;t+=2){
    STEP(pB0,pB1,pA0,pA1,t,(t+3<NT),(t+1<NT),(t+1<NT));       ENDW(t);   RESC(); ROT();
    STEP(pA0,pA1,pB0,pB1,t+1,(t+4<NT),(t+2<NT),(t+2<NT));     ENDW(t+1); RESC(); ROT();
  }
  STEP(pB0,pB1,pA0,pA1,NT-1,false,false,false); RESC();
  { float sacc=pB0[0]+pB0[1]; _Pragma("unroll") for(int r=2;r<16;++r)sacc+=pB0[r]; _Pragma("unroll") for(int r=0;r<16;++r)sacc+=pB1[r]; l_reg+=sacc;
    pw0=(u32x4){PKW(pB0,0),PKW(pB0,2),PKW(pB0,4),PKW(pB0,6)};pw1=(u32x4){PKW(pB0,8),PKW(pB0,10),PKW(pB0,12),PKW(pB0,14)};pw2=(u32x4){PKW(pB1,0),PKW(pB1,2),PKW(pB1,4),PKW(pB1,6)};pw3=(u32x4){PKW(pB1,8),PKW(pB1,10),PKW(pB1,12),PKW(pB1,14)};
    SBAR(); pv(o,vb0+sl_cur,PAF(0),PAF(1),PAF(2),PAF(3)); }
  #undef PKW
  #undef PAF
  #undef VFR
  #undef PIN
  #undef MX3
  #undef GAPA
  #undef GAPB
  #undef EX
  #undef VRD
  #undef KRD
  #undef STEP
  #undef ENDW
  {auto rr=__builtin_amdgcn_permlane32_swap(__float_as_uint(l_reg),__float_as_uint(l_reg),false,false);l_reg=__uint_as_float(rr[0])+__uint_as_float(rr[1]);}
  if(hi==0)wsf[32+r32]=l_reg;asm volatile("s_waitcnt lgkmcnt(0)":::"memory");
  float rli[16];
  #pragma unroll
  for(int r=0;r<16;++r)rli[r]=__builtin_amdgcn_rcpf(wsf[32+crow(r,hi)]);
  bf16*Ow=O+(rowbase+q0+wid*QBLK)*OPITCH+h*D;
  { bf16*stg=(bf16*)(shm+LDS_OST)+wid*2048;
    #pragma unroll
    for(int r=0;r<16;++r){const int orow=crow(r,hi);
      #pragma unroll
      for(int d0=0;d0<2;++d0)stg[orow*64+d0*32+r32]=__float2bfloat16(o[d0][r]*rli[r]);}
    asm volatile("s_waitcnt lgkmcnt(0)":::"memory");
    #pragma unroll
    for(int i=0;i<4;++i){const int row=i*8+(lane>>3),ch=lane&7; const u32x4 v=*(const u32x4*)(stg+row*64+ch*8); ATTN_STORE16(Ow+(long)row*OPITCH+ch*8,v);} }
  asm volatile("s_waitcnt lgkmcnt(0)\n\ts_barrier":::"memory");
  #undef DMA_K
  #undef DMA_V
  #undef CMASK
  #undef START
  #undef RESC
  #undef ROT
}
constexpr int ATTN_LDS_BYTES=LDS_BYTES;
struct AttnTensors { const bf16* Q; const bf16* K; const bf16* V; const float* F2; bf16* O; };
struct AttnUnit { int bh; int qb; };
struct StaticOrder {
  int vcu;
  __device__ __forceinline__ explicit StaticOrder(int grid,int block):vcu((block%8)*(grid/8)+block/8){}
  __device__ __forceinline__ bool next(int i,AttnUnit&u)const{ if(i>=2||vcu>=256)return false; const int s=vcu&15; u.bh=vcu>>4; u.qb=(i==0)?s:31-s; return true; }
  __device__ __forceinline__ void a_ready(const AttnUnit&)const{}
  __device__ __forceinline__ void done(const AttnUnit&)const{}
};
template<class Sched,int THRL=8> __device__ __forceinline__ void attn_phase(char*lds,const AttnTensors&T,const Sched&S){
  AttnUnit u;
  for(int i=0;S.next(i,u);++i){ S.a_ready(u); attn_unit<THRL>(u.bh/NHEAD,u.bh%NHEAD,u.qb,0,T.Q,T.K,T.V,T.F2,T.O,lds); S.done(u); }
}
#undef SBAR
#undef WAIT_BAR
}
typedef float f32x4m __attribute__((ext_vector_type(4)));
__device__ __forceinline__ float bf2f(unsigned short b) { return __uint_as_float((unsigned)b << 16); }
__device__ __forceinline__ void gla_chunk_item(Frame& F, int item) {
    const int h = item & 3, c = (item >> 2) & 127, b = item >> 9, tid = F.tid, lane = F.lane, wid = F.wave;
    const size_t row0 = (size_t)b * SEQ + c * 64;
    LAS float* L = (LAS float*)(F.lds + RING_OFF); LAS float* glw = L; LAS float* la = L + 1024; LAS float* seg = L + 5120; LAS float* kd = L + 5632; LAS float* vs = L + 9728;
    const bf16* P1 = (const bf16*)(F.ws + WS_P1); const bf16* GK = P1 + (size_t)3 * M * 512 + (size_t)M * 256; const bf16* GV = P1 + (size_t)4 * M * 512;
    const float* GLOW = (const float*)(F.ws + WS_GLOW);
    const int dk = tid & 63, tq = tid >> 6;
    for (int i = tid; i < 256; i += 512) ((LAS f32x4m*)glw)[i] = ((const GAS f32x4m*)(GLOW + row0 * 16))[i];
#pragma unroll
    for (int j = 0; j < 2; ++j) { const int ch = tid + 512 * j, r = ch >> 4, c8 = (ch & 15) * 8; const v4u raw = *(const GAS v4u*)(GV + (row0 + r) * 512 + h * 128 + c8);
        LAS float* d = vs + r * 128 + c8;
        d[0] = __uint_as_float(raw.x << 16); d[1] = __uint_as_float(raw.x & 0xffff0000u); d[2] = __uint_as_float(raw.y << 16); d[3] = __uint_as_float(raw.y & 0xffff0000u);
        d[4] = __uint_as_float(raw.z << 16); d[5] = __uint_as_float(raw.z & 0xffff0000u); d[6] = __uint_as_float(raw.w << 16); d[7] = __uint_as_float(raw.w & 0xffff0000u); }
    float gu[16];
#pragma unroll
    for (int r = 0; r < 16; ++r) gu[r] = F.gup[r * 256 + h * 64 + dk];
    const float gbv = F.gbias[h * 64 + dk];
    float kv[8];
#pragma unroll
    for (int i = 0; i < 8; ++i) kv[i] = bf2f(GK[(row0 + 8 * tq + i) * 256 + h * 64 + dk]);
    __syncthreads();
    float run = 0.f;
#pragma unroll
    for (int i = 0; i < 8; ++i) { const int t = 8 * tq + i; float s = gbv;
#pragma unroll
        for (int r = 0; r < 16; ++r) s = fmaf(glw[t * 16 + r], gu[r], s);
        run += log_sigmoid_f(s) * (1.f / 16.f); la[t * 64 + dk] = run; }
    seg[tq * 64 + dk] = run;
    __syncthreads();
    float off = 0.f, total = 0.f;
#pragma unroll
    for (int q = 0; q < 8; ++q) { const float sv = seg[q * 64 + dk]; total += sv; if (q < tq) off += sv; }
#pragma unroll
    for (int i = 0; i < 8; ++i) { const int t = 8 * tq + i; kd[t * 64 + dk] = kv[i] * __expf(total - (la[t * 64 + dk] + off)); }
    if (tq == 0) ((float*)(F.ws + WS_DECAY))[((size_t)(b * 128 + c) * 4 + h) * 64 + dk] = __expf(total);
    __syncthreads();
    const int mb = wid & 3, nb0 = (wid >> 2) * 4, l15 = lane & 15, l4 = lane >> 4;
    f32x4m acc[4];
#pragma unroll
    for (int n = 0; n < 4; ++n) acc[n] = (f32x4m){0.f, 0.f, 0.f, 0.f};
#pragma unroll 4
    for (int ks = 0; ks < 16; ++ks) { const int t = 4 * ks + l4; const float a = kd[t * 64 + mb * 16 + l15];
#pragma unroll
        for (int n = 0; n < 4; ++n) acc[n] = __builtin_amdgcn_mfma_f32_16x16x4f32(a, vs[t * 128 + (nb0 + n) * 16 + l15], acc[n], 0, 0, 0); }
    float* up = (float*)(F.ws + WS_UPD) + ((size_t)(b * 128 + c) * 4 + h) * 64 * 128;
#pragma unroll
    for (int n = 0; n < 4; ++n)
#pragma unroll
        for (int r = 0; r < 4; ++r) up[(mb * 16 + 4 * l4 + r) * 128 + (nb0 + n) * 16 + l15] = acc[n][r];
    __syncthreads();
}
__device__ __forceinline__ void fscan_item(Frame& F, int bh) {
    const int b = bh >> 3, h = bh & 7, tid = F.tid, lane = F.lane, wid = F.wave;
    const float* src = (const float*)(F.ws + WS_FLT) + (size_t)h * M + (size_t)b * SEQ + 16 * tid;
    f32x4m v[4];
#pragma unroll
    for (int j = 0; j < 4; ++j) v[j] = ((const GAS f32x4m*)src)[j];
    double loc[16]; double run = 0.0;
#pragma unroll
    for (int j = 0; j < 4; ++j)
#pragma unroll
        for (int i = 0; i < 4; ++i) { run += (double)v[j][i]; loc[4 * j + i] = run; }
    double inc = run;
#pragma unroll
    for (int o = 1; o < 64; o <<= 1) { const double up = __shfl_up(inc, o); if (lane >= o) inc += up; }
    LAS double* wt = (LAS double*)(F.lds + RING_OFF);
    if (lane == 63) wt[wid] = inc;
    __syncthreads();
    double base = inc - run;
#pragma unroll
    for (int w = 0; w < 8; ++w) if (w < wid) base += wt[w];
    float* dst = (float*)(F.ws + WS_F2) + (size_t)bh * SEQ + 16 * tid;
#pragma unroll
    for (int j = 0; j < 4; ++j) { f32x4m o;
#pragma unroll
        for (int i = 0; i < 4; ++i) o[i] = (float)(base + loc[4 * j + i]);
        ((GAS f32x4m*)dst)[j] = o; }
    __syncthreads();
}
__device__ __forceinline__ void gla_scan(Frame& F, size_t dst_off = 0) {
    if (F.tid >= 256) return;
    const int nel = BATCH * GH * 64 * 128;
    for (int id = F.vcu * 256 + F.tid; id < nel; id += F.G * 256) {
        const int dv = id & 127, dkk = (id >> 7) & 63, h = (id >> 13) & 3, b = id >> 15;
        float* up = (float*)(F.ws + WS_UPD) + ((size_t)(b * 128) * 4 + h) * 64 * 128 + dkk * 128 + dv; const float* dc = (const float*)(F.ws + WS_DECAY) + ((size_t)(b * 128) * 4 + h) * 64 + dkk;
        float st = 0.f;
        for (int c0 = 0; c0 < 128; c0 += 16) { float u[16], d[16];
#pragma unroll
            for (int j = 0; j < 16; ++j) { u[j] = up[(size_t)(c0 + j) * 4 * 64 * 128]; d[j] = dc[(size_t)(c0 + j) * 4 * 64]; }
#pragma unroll
            for (int j = 0; j < 16; ++j) { st = fmaf(d[j], st, u[j]); up[dst_off + (size_t)(c0 + j) * 4 * 64 * 128] = st; } }
    }
}
__device__ __forceinline__ void gla_out_item(Frame& F, int item) {
    const int h = item & 3, c = (item >> 2) & 127, b = item >> 9, tid = F.tid, lane = F.lane, wid = F.wave;
    const size_t row0 = (size_t)b * SEQ + c * 64;
    LAS float* L = (LAS float*)(F.lds + RING_OFF); LAS float* qs = L; LAS float* st = L + 4160; LAS float* ssq = L + 12352; LAS float* ob = L + 12480;
    const bf16* P1 = (const bf16*)(F.ws + WS_P1); const bf16* GQ = P1 + (size_t)3 * M * 512; const bf16* GO = P1 + (size_t)5 * M * 512;
    const float* sp = (const float*)(F.ws + WS_UPD) + ((size_t)(b * 128 + c) * 4 + h) * 64 * 128;
#pragma unroll
    for (int j = 0; j < 4; ++j) ((LAS f32x4m*)st)[tid + 512 * j] = ((const GAS f32x4m*)sp)[tid + 512 * j];
    { const int r = tid >> 3, c8 = (tid & 7) * 8; const v4u raw = *(const GAS v4u*)(GQ + (row0 + r) * 256 + h * 64 + c8); LAS float* d = qs + r * 65 + c8;
      d[0] = __uint_as_float(raw.x << 16); d[1] = __uint_as_float(raw.x & 0xffff0000u); d[2] = __uint_as_float(raw.y << 16); d[3] = __uint_as_float(raw.y & 0xffff0000u);
      d[4] = __uint_as_float(raw.z << 16); d[5] = __uint_as_float(raw.z & 0xffff0000u); d[6] = __uint_as_float(raw.w << 16); d[7] = __uint_as_float(raw.w & 0xffff0000u); }
    __syncthreads();
    const int mb = wid & 3, nb0 = (wid >> 2) * 4, l15 = lane & 15, l4 = lane >> 4;
    f32x4m acc[4];
#pragma unroll
    for (int n = 0; n < 4; ++n) acc[n] = (f32x4m){0.f, 0.f, 0.f, 0.f};
#pragma unroll 4
    for (int ks = 0; ks < 16; ++ks) { const int kk = 4 * ks + l4; const float a = qs[(mb * 16 + l15) * 65 + kk];
#pragma unroll
        for (int n = 0; n < 4; ++n) acc[n] = __builtin_amdgcn_mfma_f32_16x16x4f32(a, st[kk * 128 + (nb0 + n) * 16 + l15], acc[n], 0, 0, 0); }
#pragma unroll
    for (int r = 0; r < 4; ++r) { float s = 0.f;
#pragma unroll
        for (int n = 0; n < 4; ++n) s += acc[n][r] * acc[n][r];
        s += __shfl_xor(s, 1); s += __shfl_xor(s, 2); s += __shfl_xor(s, 4); s += __shfl_xor(s, 8);
        if (l15 == 0) ssq[(wid >> 2) * 64 + mb * 16 + 4 * l4 + r] = s;
#pragma unroll
        for (int n = 0; n < 4; ++n) ob[(mb * 16 + 4 * l4 + r) * 132 + (nb0 + n) * 16 + l15] = acc[n][r]; }
    __syncthreads();
    { const int t = tid >> 3, d0 = (tid & 7) * 16; const float rs = 1.f / sqrtf((ssq[t] + ssq[64 + t]) * (1.f / 128.f) + EPS);
      const v4u g0 = *(const GAS v4u*)(GO + (row0 + t) * 512 + h * 128 + d0), g1 = *(const GAS v4u*)(GO + (row0 + t) * 512 + h * 128 + d0 + 8);
      const unsigned gw[8] = {g0.x, g0.y, g0.z, g0.w, g1.x, g1.y, g1.z, g1.w}; unsigned ow[8];
#pragma unroll
      for (int j = 0; j < 8; ++j) { const float ga = __uint_as_float(gw[j] << 16), gb2 = __uint_as_float(gw[j] & 0xffff0000u);
          const float oa = ob[t * 132 + d0 + 2 * j] * rs * F.gng[d0 + 2 * j] * (ga * __builtin_amdgcn_rcpf(1.f + __expf(-ga)));
          const float obv = ob[t * 132 + d0 + 2 * j + 1] * rs * F.gng[d0 + 2 * j + 1] * (gb2 * __builtin_amdgcn_rcpf(1.f + __expf(-gb2)));
          ow[j] = pk2(oa, obv); }
      bf16* dst = (bf16*)(F.ws + WS_CAT) + (row0 + t) * D + 512 + h * 128 + d0;
      *(GAS v4u*)dst = (v4u){ow[0], ow[1], ow[2], ow[3]}; *(GAS v4u*)(dst + 8) = (v4u){ow[4], ow[5], ow[6], ow[7]}; }
    __syncthreads();
}

__device__ __forceinline__ void qk_norms(Frame& F) {
    const int tid = F.tid, lane = F.lane, wid = F.wave;
    LAS unsigned* red = (LAS unsigned*)(F.lds + RING_OFF);
    const bf16* QF = (const bf16*)(F.ws + WS_P1); const bf16* KF = QF + (size_t)M * 512;
    for (int rb = F.vcu; rb < M / 64; rb += F.G) {
        const size_t off = ((size_t)rb * 64 + (tid >> 3)) * 512 + (tid & 7) * 64; float sq = 0.f, sk = 0.f;
#pragma unroll
        for (int j = 0; j < 8; ++j) { const v4u a = *(const GAS v4u*)(QF + off + 8 * j), c = *(const GAS v4u*)(KF + off + 8 * j);
            const unsigned aw[4] = {a.x, a.y, a.z, a.w}, cw[4] = {c.x, c.y, c.z, c.w};
#pragma unroll
            for (int i = 0; i < 4; ++i) { const float a0 = __uint_as_float(aw[i] << 16), a1 = __uint_as_float(aw[i] & 0xffff0000u), c0 = __uint_as_float(cw[i] << 16), c1 = __uint_as_float(cw[i] & 0xffff0000u);
                sq = fmaf(a0, a0, fmaf(a1, a1, sq)); sk = fmaf(c0, c0, fmaf(c1, c1, sk)); } }
#pragma unroll
        for (int o = 8; o < 64; o <<= 1) { sq = fmaxf(sq, __shfl_xor(sq, o)); sk = fmaxf(sk, __shfl_xor(sk, o)); }
        if (lane < 8) { red[wid * 8 + lane] = __float_as_uint(sq); red[64 + wid * 8 + lane] = __float_as_uint(sk); }
        __syncthreads();
        if (tid < 16) { const int hh = tid & 7, which = tid >> 3; unsigned m = 0u;
#pragma unroll
            for (int w = 0; w < 8; ++w) { const unsigned r = red[which * 64 + w * 8 + hh]; m = r > m ? r : m; }
            const int b = (rb * 64) / SEQ; __hip_atomic_fetch_max(F.ctl + CW_QKN + 64 * (which * 16 + b * 8 + hh), m, RLX_AGENT); }
        __syncthreads();
    }
}
constexpr float PRUNE_LOG2 = 40.f;
__device__ __forceinline__ void build_unit_table(Frame& F) {
    LAS int* cst = (LAS int*)(F.lds + RING_OFF); LAS int* t0s = cst + 512;
    const float* F2 = (const float*)(F.ws + WS_F2);
    if (F.tid >= 256) {
#pragma unroll 1
        for (int rep = 0; rep < 2; ++rep) { const int u = F.tid - 256 + 256 * rep, bh = u >> 5, qb = u & 31;
            const float qn = __uint_as_float(__hip_atomic_load(F.ctl + CW_QKN + 64 * bh, RLX_AGENT)), kn = __uint_as_float(__hip_atomic_load(F.ctl + CW_QKN + 64 * (16 + bh), RLX_AGENT));
            const float thr = -(PRUNE_LOG2 + 2.f * sqrtf(qn * kn) * 1.0001f); const float* Fr = F2 + (size_t)bh * SEQ; const float fq0 = Fr[256 * qb];
            int lo = 0, hi = 4 * qb;
            while (lo < hi) { const int mid = (lo + hi) >> 1; if (fq0 - Fr[64 * mid + 63] >= thr) hi = mid; else lo = mid + 1; }
            const int T0 = lo & ~1; cst[u] = 4 * qb + 4 - T0; t0s[u] = T0; }
    }
    __syncthreads();
    if (F.tid >= 256) {
#pragma unroll 1
        for (int rep = 0; rep < 2; ++rep) { const int u = F.tid - 256 + 256 * rep, my = cst[u]; int rank = 0;
            for (int v = 0; v < 512; ++v) { const int c = cst[v]; rank += (c > my || (c == my && v < u)) ? 1 : 0; }
            ((int*)(F.ws + WS_UTAB))[rank] = u | (t0s[u] << 16); }
    }
    __syncthreads();
}
constexpr int RW_LD = 1028;
constexpr int RT_RW = 0, RT_LOG = 32 * RW_LD * 4, RT_HIST = RT_LOG + 64 * 33 * 4, RT_BASE = RT_HIST + 128, RT_END = RT_BASE + 128;
static_assert(RT_END + 3 * 1024 <= LDSCTL_OFF, "router LDS map");
template <bool DRY = false> __device__ __forceinline__ void p6_router(Frame& F) {
    const int tid = F.tid, wid = F.wave; int lane = F.lane; asm volatile("" : "+v"(lane));
    LAS float* rwt = (LAS float*)(F.lds + RT_RW); LAS float* lg = (LAS float*)(F.lds + RT_LOG); LAS int* hist = (LAS int*)(F.lds + RT_HIST); LAS int* base = (LAS int*)(F.lds + RT_BASE);
    for (int it = 0; it < 64; ++it) { const int i = tid + 512 * it, k = i >> 5, e = i & 31; rwt[e * RW_LD + k] = F.rw[i]; }
    if (tid < 32) hist[tid] = 0;
    __syncthreads();
    const float* H = (const float*)(F.ws + WS_H); bf16* XN = (bf16*)(F.ws + WS_XN);
    f32x4 gv[4];
#pragma unroll
    for (int j = 0; j < 4; ++j) gv[j] = ((const GAS f32x4*)F.n2g)[lane + 64 * j];
    for (int rr = 0; rr < 8; ++rr) {
        const int rl = wid * 8 + rr, m = F.vcu * 64 + rl;
        const GAS f32x4* xr = (const GAS f32x4*)(H + (size_t)m * D) + lane;
        f32x4 v[4]; float s = 0.f;
#pragma unroll
        for (int j = 0; j < 4; ++j) { v[j] = xr[64 * j]; s += (v[j].x * v[j].x + v[j].y * v[j].y) + (v[j].z * v[j].z + v[j].w * v[j].w); }
        const float rstd = 1.f / sqrtf(wave_sum(s) * (1.f / D) + EPS);
        GAS unsigned long long* o8 = (GAS unsigned long long*)(XN + (size_t)m * D) + lane;
#pragma unroll
        for (int j = 0; j < 4; ++j) { v[j] = v[j] * rstd * gv[j]; o8[64 * j] = (unsigned long long)pk2(v[j].x, v[j].y) | ((unsigned long long)pk2(v[j].z, v[j].w) << 32); }
        float a[32];
#pragma unroll
        for (int e = 0; e < 32; ++e) { float t = 0.f;
#pragma unroll
            for (int j = 0; j < 4; ++j) { const f32x4 w = *(const LAS f32x4*)(rwt + e * RW_LD + 256 * j + 4 * lane); t += (v[j].x * w.x + v[j].y * w.y) + (v[j].z * w.z + v[j].w * w.w); }
            a[e] = t; if ((e & 3) == 3) asm volatile("" ::: "memory"); }
        const float tot = bfly32(a, lane);
        if ((lane & 1) == 0) lg[rl * 33 + (lane >> 1)] = tot + F.rb[lane >> 1];
    }
    __syncthreads();
    LAS int* selL = (LAS int*)(F.lds + RT_END); LAS int* rankL = selL + 256; LAS float* gtL = (LAS float*)(rankL + 256);
    if (tid < 64) {
        float v[32];
#pragma unroll
        for (int e = 0; e < 32; ++e) v[e] = lg[tid * 33 + e];
        int sel[4] = {0, 0, 0, 0}; float sv[4];
#pragma unroll
        for (int k = 0; k < 4; ++k) { int bi = 0; float bv = -INFINITY;
#pragma unroll
            for (int e = 0; e < 32; ++e) { bool taken = false;
#pragma unroll
                for (int kk = 0; kk < 4; ++kk) if (kk < k && sel[kk] == e) taken = true;
                if (!taken && v[e] > bv) { bv = v[e]; bi = e; } }
            sel[k] = bi; sv[k] = bv; }
        float gt[4], sum = 0.f;
#pragma unroll
        for (int k = 0; k < 4; ++k) { gt[k] = __expf(sv[k] - sv[0]); sum += gt[k]; }
        const float inv = 1.f / sum;
#pragma unroll
        for (int k = 0; k < 4; ++k) { selL[tid * 4 + k] = sel[k]; gtL[tid * 4 + k] = gt[k] * inv; rankL[tid * 4 + k] = __hip_atomic_fetch_add(hist + sel[k], 1, __ATOMIC_RELAXED, __HIP_MEMORY_SCOPE_WORKGROUP); }
    }
    __syncthreads();
    if (DRY) return;
    if (tid < 32) { const int hcount = hist[tid]; base[tid] = hcount ? (int)__hip_atomic_fetch_add(F.ctl + CW_ECNT + 64 * tid, (unsigned)hcount, RLX_AGENT) : 0; }
    __syncthreads();
    if (tid < 256) { const int m = F.vcu * 64 + (tid >> 2), e = selL[tid], idx = base[e] + rankL[tid];
        unsigned char* wsb = F.ws;
        ((int*)(wsb + WS_TOKL))[(size_t)e * ECAP + idx] = m; ((int*)(wsb + WS_PIDX))[m * 4 + (tid & 3)] = idx; ((int*)(wsb + WS_EIDX))[m * 4 + (tid & 3)] = e; ((float*)(wsb + WS_GATE))[m * 4 + (tid & 3)] = gtL[tid]; }
}
constexpr int MOE_MAX_UNITS = 26;
__device__ __forceinline__ void moe_tables(Frame& F) {
    LAS int* tab = (LAS int*)(F.lds + EXTRA_OFF);
    __syncthreads();
    if (F.tid < 32) tab[128 + F.tid] = (int)__hip_atomic_load(F.ctl + CW_ECNT + 64 * F.tid, RLX_AGENT);
    __syncthreads();
    if (F.tid == 0) { int a = 0; for (int e = 0; e < 32; ++e) { tab[e] = a; tab[64 + e] = a * 256; a += (tab[128 + e] + 255) >> 8; } tab[32] = a; }
    __syncthreads();
}
template <class Sched> __device__ __forceinline__ void moe_fill_toks(Frame& F, const Sched& S) {
    LAS int* tab = (LAS int*)(F.lds + EXTRA_OFF); LAS int* toks = tab + 256; const int* TOKL = (const int*)(F.ws + WS_TOKL);
    pg8::Unit u;
    for (int i = 0; i < MOE_MAX_UNITS && S.next(i, u); ++i) if (F.tid < 256) { const int idx = (u.pm & 0xffff) * 256 + F.tid; toks[i * 256 + F.tid] = (idx < tab[128 + u.e]) ? TOKL[(size_t)u.e * ECAP + idx] : 0; }
    __syncthreads();
}
__device__ __forceinline__ void p9_combine(Frame& F) {
    int lane = F.lane; asm volatile("" : "+v"(lane)); const LAS int* tab = (const LAS int*)(F.lds + EXTRA_OFF);
    const float* H = (const float*)(F.ws + WS_H); const bf16* Y = (const bf16*)(F.ws + WS_Y);
    const int* PIDX = (const int*)(F.ws + WS_PIDX); const int* EIDX = (const int*)(F.ws + WS_EIDX); const float* GATE = (const float*)(F.ws + WS_GATE);
    f32x4 gv[4];
#pragma unroll
    for (int j = 0; j < 4; ++j) gv[j] = ((const GAS f32x4*)F.fg)[lane + 64 * j];
    const int gw = F.vcu * NWAVES + F.wave, NGW = F.G * NWAVES;
    for (int m = gw; m < M; m += NGW) {
        f32x4 v[4];
#pragma unroll
        for (int j = 0; j < 4; ++j) v[j] = ((const GAS f32x4*)(H + (size_t)m * D))[lane + 64 * j];
#pragma unroll
        for (int k = 0; k < 4; ++k) { const int e = EIDX[m * 4 + k]; const size_t slot = (size_t)tab[64 + e] + PIDX[m * 4 + k]; const float g = GATE[m * 4 + k];
            const GAS unsigned long long* yr = (const GAS unsigned long long*)(Y + slot * D) + lane;
#pragma unroll
            for (int j = 0; j < 4; ++j) { const unsigned long long w = yr[64 * j]; const unsigned lo = (unsigned)w, hi = (unsigned)(w >> 32);
                v[j].x = fmaf(g, __uint_as_float(lo << 16), v[j].x); v[j].y = fmaf(g, __uint_as_float(lo & 0xffff0000u), v[j].y);
                v[j].z = fmaf(g, __uint_as_float(hi << 16), v[j].z); v[j].w = fmaf(g, __uint_as_float(hi & 0xffff0000u), v[j].w); } }
        float s = 0.f;
#pragma unroll
        for (int j = 0; j < 4; ++j) s += (v[j].x * v[j].x + v[j].y * v[j].y) + (v[j].z * v[j].z + v[j].w * v[j].w);
        const float rstd = 1.f / sqrtf(wave_sum(s) * (1.f / D) + EPS);
#pragma unroll
        for (int j = 0; j < 4; ++j) ((GAS f32x4*)(F.out + (size_t)m * D))[lane + 64 * j] = v[j] * rstd * gv[j];
    }
}

struct Args { const float* in[16]; float* out; unsigned char* ws; int ph_lo, ph_hi; };
constexpr int N_PHASES = 10;
__global__ void __launch_bounds__(NWAVES * 64, 2) mk_fwd(Args args) {
    extern __shared__ __attribute__((aligned(16))) unsigned char lds[];
    Frame F;
    F.lds = (LAS unsigned char*)lds; F.MISC = (volatile LAS unsigned*)(F.lds + MISC_OFF);
    F.tid = threadIdx.x; F.lane = F.tid & 63; F.wave = __builtin_amdgcn_readfirstlane(F.tid >> 6);
    F.G = gridDim.x; { const int bx = blockIdx.x; F.vcu = (F.G % 8 == 0) ? (bx % 8) * (F.G / 8) + bx / 8 : bx; }
    unsigned char* ws = args.ws; F.ws = ws; F.ctl = (gu32*)(ws + WS_CTL);
    F.x = args.in[0]; F.n1g = args.in[1]; F.w_in = args.in[2]; F.fbias = args.in[3]; F.gup = args.in[4]; F.gbias = args.in[5]; F.gng = args.in[6]; F.w_out = args.in[7];
    F.n2g = args.in[8]; F.rw = args.in[9]; F.rb = args.in[10]; F.ewi = args.in[11]; F.ebi = args.in[12]; F.ewo = args.in[13]; F.ebo = args.in[14]; F.fg = args.in[15]; F.out = args.out;
    for (int u = F.tid; u < (LDS_BYTES - LDSCTL_OFF) / 4; u += NWAVES * 64) ((LAS unsigned*)(F.lds + LDSCTL_OFF))[u] = 0u;
    __syncthreads();
    const int lo = args.ph_lo, hi = args.ph_hi;
    const bool one_phase = (hi - lo) == 1;
    XcdBarrier bar; bar.bar = (unsigned*)(F.ctl + CW_BAR); bar.x = 0; bar.st = nullptr;
    if (!one_phase) bar = xcd_barrier_post((unsigned*)(F.ctl + CW_BAR), F.MISC + 8);
#define IN(k) (lo <= (k) && (k) < hi)
#define BOTH(k) (IN(k) && IN((k) + 1))
#define GRID_BAR() xcd_barrier(bar)
#ifndef PROBE_DUP
#define PROBE_DUP -1
#endif
#define DUP_BEGIN(k) _Pragma("unroll") for (int rep_ = 0; rep_ < ((k) == PROBE_DUP ? 2 : 1); ++rep_) {
#define DUP_END }
#define REFRESH() do { int t_ = threadIdx.x; asm volatile("" : "+v"(t_)); F.tid = t_; F.lane = t_ & 63; } while (0)

#ifndef SKIP_P0
    if (IN(0)) { REFRESH(); DUP_BEGIN(0) p0_prologue(F); DUP_END if (BOTH(0)) GRID_BAR(); }
#endif
#ifndef SKIP_P1
    if (IN(1)) { REFRESH(); DUP_BEGIN(1)
        pg8::Gemm g{(const pg8::bf16_t*)(ws + WS_XN), (const pg8::bf16_t*)(ws + WS_WIN), M, NPROJ, D}; pg8::StaticOrder S; S.init(M, NPROJ, F.G, (int)blockIdx.x);
        pg8::EpiRoute E{(pg8::bf16_t*)(ws + WS_P1), M, C2};
        pg8::gemm_phase<pg8::EpiRoute, pg8::StaticOrder, true, true>(F.lds + RING_OFF, g, S, E);
        DUP_END if (BOTH(1)) GRID_BAR();
    }
#endif
    if (IN(2)) { REFRESH(); DUP_BEGIN(2)
        if (F.vcu < BATCH * FH) fscan_item(F, F.vcu);
        qk_norms(F);
        for (int it = F.vcu; it < BATCH * 128 * GH; it += F.G) gla_chunk_item(F, it);
        DUP_END if (BOTH(2)) GRID_BAR();
    }
    if (IN(3)) { REFRESH(); DUP_BEGIN(3) gla_scan(F, (PROBE_DUP == 3 && rep_ == 0) ? (WS_ACT - WS_UPD) / 4 : 0); DUP_END if (blockIdx.x == 0) build_unit_table(F); if (BOTH(3)) GRID_BAR(); }
    if (IN(4)) { REFRESH(); DUP_BEGIN(4)
        const bf16* P1 = (const bf16*)(ws + WS_P1); LAS int* qslot = (LAS int*)(F.lds + EXTRA_OFF);
        for (;;) {
            if (F.tid == 0) qslot[0] = (int)__hip_atomic_fetch_add(F.ctl + CW_QUEUE + (PROBE_DUP == 4 ? 128 * rep_ : 0), 1u, RLX_AGENT);
            __syncthreads();
            const int q = __builtin_amdgcn_readfirstlane(qslot[0]);
            __syncthreads();
            if (q >= 512) break;
            const int e = __builtin_amdgcn_readfirstlane(((const int*)(ws + WS_UTAB))[q]), u = e & 0xffff, T0 = e >> 16;
            attn_body::attn_unit<8>(u >> 8, (u >> 5) & 7, u & 31, T0, (const attn_body::bf16*)P1, (const attn_body::bf16*)(P1 + (size_t)M * 512), (const attn_body::bf16*)(P1 + (size_t)2 * M * 512),
                                    (const float*)(ws + WS_F2), (attn_body::bf16*)(ws + WS_CAT), (char*)lds + RING_OFF);
        }
        for (;;) {
            if (F.tid == 0) qslot[0] = (int)__hip_atomic_fetch_add(F.ctl + CW_QUEUE + 64 + (PROBE_DUP == 4 ? 128 * rep_ : 0), 1u, RLX_AGENT);
            __syncthreads();
            const int p5 = __builtin_amdgcn_readfirstlane(qslot[0]);
            __syncthreads();
            if (p5 >= 5 * 512) break;
            const int g5 = p5 / 5, r5 = p5 % 5;
            if (r5 == 2 || r5 == 4) gla_out_item(F, 2 * g5 + (r5 >> 2)); else conv_batch(F, 3 * g5 + (r5 == 3 ? 2 : r5));
        }
        DUP_END if (BOTH(4)) GRID_BAR();
    }
#ifndef SKIP_P5
    if (IN(5)) { REFRESH(); DUP_BEGIN(5)
        pg8::Gemm g{(const pg8::bf16_t*)(ws + WS_CAT), (const pg8::bf16_t*)(ws + WS_WOUT), M, D, D}; pg8::StaticOrder S; S.init(M, D, F.G, (int)blockIdx.x);
        pg8::EpiResF32 E{F.x, (float*)(ws + WS_H), D};
        pg8::gemm_phase<pg8::EpiResF32, pg8::StaticOrder, false, true>(F.lds + RING_OFF, g, S, E);
        DUP_END if (BOTH(5)) GRID_BAR();
    }
#endif
#ifndef SKIP_P6
    if (IN(6)) { REFRESH(); if (PROBE_DUP == 6) { if (F.vcu < M / 64) p6_router<true>(F); __syncthreads(); } if (F.vcu < M / 64) p6_router<false>(F); if (BOTH(6)) GRID_BAR(); }
#endif
#ifndef SKIP_P7
    if (IN(7)) { REFRESH(); DUP_BEGIN(7)
        moe_tables(F);
        pg8::Gemm g{(const pg8::bf16_t*)(ws + WS_XN), (const pg8::bf16_t*)(ws + WS_E1), M, 2048, D};
        pg8::MoeOrder<true> S; S.init((const LAS int*)(F.lds + EXTRA_OFF), (const LAS int*)(F.lds + EXTRA_OFF) + 256, 8, F.G, (int)blockIdx.x);
        moe_fill_toks(F, S);
        pg8::EpiSwiglu E{(pg8::bf16_t*)(ws + WS_ACT), D, F.ebi};
        pg8::gemm_phase<pg8::EpiSwiglu, pg8::MoeOrder<true>, true, true>(F.lds + RING_OFF, g, S, E);
        DUP_END if (BOTH(7)) GRID_BAR();
    }
#endif
#ifndef SKIP_P8
    if (IN(8)) { REFRESH(); DUP_BEGIN(8)
        moe_tables(F);
        pg8::Gemm g{(const pg8::bf16_t*)(ws + WS_ACT), (const pg8::bf16_t*)(ws + WS_E2), M, D, D};
        pg8::MoeOrder<false> S; S.init((const LAS int*)(F.lds + EXTRA_OFF), (const LAS int*)(F.lds + EXTRA_OFF) + 256, 4, F.G, (int)blockIdx.x);
        pg8::EpiBiasBf16 E{(pg8::bf16_t*)(ws + WS_Y), D, F.ebo};
        pg8::gemm_phase<pg8::EpiBiasBf16, pg8::MoeOrder<false>, true, true>(F.lds + RING_OFF, g, S, E);
        DUP_END if (BOTH(8)) GRID_BAR();
    }
#endif
#ifndef SKIP_P9
    if (IN(9)) { REFRESH(); DUP_BEGIN(9) moe_tables(F); p9_combine(F); DUP_END }
#endif

#undef IN
#undef BOTH
}

static int mk_grid() {
    static int grid = 0;
    if (grid == 0) {
        int dev = 0, cus = 0;
        if (hipGetDevice(&dev) != hipSuccess || hipDeviceGetAttribute(&cus, hipDeviceAttributeMultiprocessorCount, dev) != hipSuccess) { grid = -1; return grid; }
        if (hipFuncSetAttribute((const void*)mk_fwd, hipFuncAttributeMaxDynamicSharedMemorySize, LDS_BYTES) != hipSuccess) { grid = -1; return grid; }
        int per_cu = 0;
        if (hipOccupancyMaxActiveBlocksPerMultiprocessor(&per_cu, (const void*)mk_fwd, NWAVES * 64, LDS_BYTES) != hipSuccess || per_cu < 1) { (void)hipGetLastError(); }
        grid = cus;
    }
    return grid;
}
static void mk_launch(void* const* d_in, void* d_out, void* d_ws, hipStream_t stream, int lo, int hi, int grid) {
    Args a{};
    for (int i = 0; i < 16; ++i) a.in[i] = (const float*)d_in[i];
    a.out = (float*)d_out; a.ws = (unsigned char*)d_ws; a.ph_lo = lo; a.ph_hi = hi;
    hipLaunchKernelGGL(mk_fwd, dim3(grid), dim3(NWAVES * 64), LDS_BYTES, stream, a);
}

extern "C" void kernel_launch(void* const* d_in, const int* in_sizes, int n_in, void* d_out, int out_size, void* d_ws, size_t ws_size, hipStream_t stream) {
    const int grid = mk_grid(); if (grid <= 0) return;
    if (n_in != 16 || ws_size < WS_END) return;
    (void)hipMemsetAsync((unsigned char*)d_ws + WS_CTL, 0, CTL_ZERO_BYTES, stream);
    mk_launch(d_in, d_out, d_ws, stream, 0, N_PHASES, grid);
}
```

```cpp
#include <hip/hip_runtime.h>
#include <hip/hip_bf16.h>
#include <cstdio>
#include <cstdint>
#include <cmath>


namespace pg8 {
#define PG8_LAS __attribute__((address_space(3)))
typedef unsigned short bf16_t;
typedef short bf16x8 __attribute__((ext_vector_type(8)));
typedef float f32x4 __attribute__((ext_vector_type(4)));
typedef unsigned u32x4 __attribute__((ext_vector_type(4)));
typedef int v4i32 __attribute__((ext_vector_type(4)));
typedef int v8i32 __attribute__((ext_vector_type(8)));
typedef unsigned u32x2 __attribute__((ext_vector_type(2)));
constexpr float FP8_WINV = 1.f / 32.f;
constexpr int BM = 256, BK = 64, HALF = 128, HTB = HALF * BK * 2  , STAGE_BYTES = 8 * HTB, NXCD = 8, WGM = 8;

__host__ __device__ __forceinline__ int lds_byte(int r, int c) { const int st = (r >> 4) * 2 + (c >> 5), rr = r & 15, cc = c & 31, ob = rr * 64 + cc * 2; return st * 1024 + (ob ^ (((ob >> 9) & 1) << 5)); }
__host__ __device__ __forceinline__ void stage_rc(int b, int& R, int& C) { const int st = b / 1024, sb = b % 1024, swz = sb ^ (((sb >> 9) & 1) << 5); R = (st >> 1) * 16 + swz / 64; C = (st & 1) * 32 + (swz % 64) / 2; }
__host__ __device__ __forceinline__ int perm32(int rho) { const int n = rho >> 4, i = rho & 15; return 8 * (i >> 2) + 4 * n + (i & 3); }

struct Unit { int pm, pn, e, orow; };
struct Gemm { const void* A; const void* Bt; int M, N, KB; };

struct StaticOrder {
    int nM, nN, nwg, G, c;
    __host__ __device__ void init(int M, int N, int G_, int c_) { nM = M / BM; nN = N / BM; nwg = nM * nN; G = G_; c = c_; }
    __host__ __device__ bool next(int i, Unit& u) const {
        const long L = (long)i * G + c; if (L >= nwg) return false;
        int wgid = (int)L; { const int q = nwg / NXCD, r = nwg % NXCD, xcd = wgid % NXCD, off = wgid / NXCD; wgid = (xcd < r ? xcd * (q + 1) : r * (q + 1) + (xcd - r) * q) + off; }
        const int nig = WGM * nN, gid = wgid / nig, fm = gid * WGM, gsz = (nM - fm) < WGM ? (nM - fm) : WGM;
        u.pm = fm + ((wgid % nig) % gsz); u.pn = (wgid % nig) / gsz; u.e = 0; u.orow = u.pm * BM; return true;
    }
    __device__ __forceinline__ const char* a_base(const Gemm& g, const Unit& u) const { return (const char*)g.A + (size_t)u.pm * ((size_t)BM * g.KB); }
    __device__ __forceinline__ const char* b_base(const Gemm& g, const Unit& u) const { return (const char*)g.Bt + (size_t)u.pn * ((size_t)BM * g.KB); }
    __device__ __forceinline__ void voff_a(const Gemm& g, const Unit&, const int (&RA)[2], const int (&CA)[2], unsigned (&v)[2][2]) const {
#pragma unroll
        for (int h = 0; h < 2; ++h)
#pragma unroll
            for (int i = 0; i < 2; ++i) v[h][i] = (unsigned)((RA[i] + h * HALF) * g.KB + CA[i] * 2); }
    __device__ __forceinline__ void a_ready(const Unit&) const {}
    __device__ __forceinline__ void done(const Unit&) const {}
};

template <bool GATHER_> struct MoeOrder {
    static constexpr bool GATHER = GATHER_;
    const PG8_LAS int* tab; const PG8_LAS int* toks; int nN, G, vcu, total;
    __device__ __forceinline__ void init(const PG8_LAS int* tab_, const PG8_LAS int* toks_, int nN_, int G_, int c_) {
        tab = tab_; toks = toks_; nN = nN_; G = G_; vcu = (G_ % 8 == 0) ? (c_ % 8) * (G_ / 8) + c_ / 8 : c_; total = tab_[32] * nN_; }
    __device__ __forceinline__ bool next(int i, Unit& u) const {
        const int L = i * G + vcu; if (L >= total) return false;
        const int gm = L / nN; u.pn = L % nN; int e = 0;
#pragma unroll 1
        for (int j = 1; j < 32; ++j) e += (tab[j] <= gm) ? 1 : 0;
        u.e = e; u.pm = gm - tab[e]; u.orow = tab[64 + e] + u.pm * BM; u.pm |= (i << 16);
        return true; }
    __device__ __forceinline__ const char* a_base(const Gemm& g, const Unit& u) const { return GATHER ? (const char*)g.A : (const char*)g.A + (size_t)u.orow * (size_t)g.KB; }
    __device__ __forceinline__ const char* b_base(const Gemm& g, const Unit& u) const { return (const char*)g.Bt + ((size_t)u.e * g.N + (size_t)u.pn * BM) * (size_t)g.KB; }
    __device__ __forceinline__ void voff_a(const Gemm& g, const Unit& u, const int (&RA)[2], const int (&CA)[2], unsigned (&v)[2][2]) const {
#pragma unroll
        for (int h = 0; h < 2; ++h)
#pragma unroll
            for (int i = 0; i < 2; ++i) { const int r = RA[i] + h * HALF; const int row = GATHER ? toks[(u.pm >> 16) * BM + r] : r; v[h][i] = (unsigned)(row * g.KB + CA[i] * 2); } }
    __device__ __forceinline__ void a_ready(const Unit&) const {}
    __device__ __forceinline__ void done(const Unit&) const {}
};

__device__ __forceinline__ unsigned cvt_pk_bf16(float lo, float hi) { unsigned r; asm volatile("v_cvt_pk_bf16_f32 %0, %1, %2" : "=v"(r) : "v"(lo), "v"(hi)); return r; }

__device__ __forceinline__ unsigned pk4_fp8(float a, float b, float c, float d) { int p = __builtin_amdgcn_cvt_pk_fp8_f32(a, b, 0, false); return (unsigned)__builtin_amdgcn_cvt_pk_fp8_f32(c, d, p, true); }
struct EpiRoute {
    static constexpr bool PERM = true, AFTER_DRAIN = false;
    bf16_t* O; int M; float qscale;
    __device__ __forceinline__ void operator()(const f32x4 (&acc)[2][2][4][2], const Unit& u, int wr, int wc, int fr, int fq) const {
        const int pn = u.pn; size_t off; int ld, colt; float sc = 1.f;
        if (pn < 6) { off = (size_t)(pn >> 1) * M * 512; ld = 512; colt = (pn & 1) * 256; if (pn < 2) sc = qscale; }
        else if (pn < 8) { off = (size_t)3 * M * 512 + (size_t)(pn - 6) * M * 256; ld = 256; colt = 0; if (pn == 6) sc = 0.125f; }
        else { off = (size_t)(4 + ((pn - 8) >> 1)) * M * 512; ld = 512; colt = (pn & 1) * 256; }
        bf16_t* base = O + off; const int row0 = u.orow + wr * 64 + fr, col0 = colt + wc * 32 + 8 * fq;
#pragma unroll
        for (int ai = 0; ai < 2; ++ai)
#pragma unroll
            for (int m = 0; m < 4; ++m) { bf16_t* rowp = base + (size_t)(row0 + ai * HALF + m * 16) * ld + col0;
#pragma unroll
                for (int bj = 0; bj < 2; ++bj) { const f32x4 v0 = acc[ai][bj][m][0] * sc, v1 = acc[ai][bj][m][1] * sc;
                    u32x4 w; w.x = cvt_pk_bf16(v0[0], v0[1]); w.y = cvt_pk_bf16(v0[2], v0[3]); w.z = cvt_pk_bf16(v1[0], v1[1]); w.w = cvt_pk_bf16(v1[2], v1[3]);
                    *(u32x4*)(rowp + bj * HALF) = w; } }
    }
};
struct EpiResF32 {
    static constexpr bool PERM = false, AFTER_DRAIN = false;
    const float* res; float* out; int ldc;
    __device__ __forceinline__ void operator()(const f32x4 (&acc)[2][2][4][2], const Unit& u, int wr, int wc, int fr, int fq) const {
        const int row0 = u.orow + wr * 64 + fr, col0 = u.pn * BM + wc * 32 + 4 * fq;
#pragma unroll
        for (int ai = 0; ai < 2; ++ai)
#pragma unroll
            for (int m = 0; m < 4; ++m) { const size_t off = (size_t)(row0 + ai * HALF + m * 16) * ldc + col0;
#pragma unroll
                for (int bj = 0; bj < 2; ++bj)
#pragma unroll
                    for (int n = 0; n < 2; ++n) { const f32x4 r = *(const f32x4*)(res + off + bj * HALF + n * 16); *(f32x4*)(out + off + bj * HALF + n * 16) = acc[ai][bj][m][n] + r; } }
    }
};
struct EpiSwiglu {
    static constexpr bool PERM = true, AFTER_DRAIN = false;
    unsigned char* O; int ldc; const float* bias;
    __device__ __forceinline__ void operator()(const f32x4 (&acc)[2][2][4][2], const Unit& u, int wr, int wc, int fr, int fq) const {
        const int row0 = u.orow + wr * 64 + fr, j0 = u.pn * HALF + wc * 32 + 8 * fq; const float* bg = bias + (size_t)u.e * 2048 + j0;
        f32x4 bgv[2], blv[2];
#pragma unroll
        for (int n = 0; n < 2; ++n) { bgv[n] = *(const f32x4*)(bg + 4 * n); blv[n] = *(const f32x4*)(bg + 1024 + 4 * n); }
#pragma unroll
        for (int ai = 0; ai < 2; ++ai)
#pragma unroll
            for (int m = 0; m < 4; ++m) { float a[8];
#pragma unroll
                for (int n = 0; n < 2; ++n) { const f32x4 gt = acc[ai][0][m][n] * FP8_WINV + bgv[n], ln = acc[ai][1][m][n] * FP8_WINV + blv[n];
#pragma unroll
                    for (int i = 0; i < 4; ++i) { const float g = fminf(gt[i], 7.f), l = fminf(fmaxf(ln[i], -7.f), 7.f);
                        a[4 * n + i] = (l + 1.f) * g * __builtin_amdgcn_rcpf(1.f + __builtin_amdgcn_exp2f(-1.702f * 1.4426950408889634f * g)); } }
                u32x2 w; w.x = pk4_fp8(a[0], a[1], a[2], a[3]); w.y = pk4_fp8(a[4], a[5], a[6], a[7]);
                *(u32x2*)(O + (size_t)(row0 + ai * HALF + m * 16) * ldc + j0) = w; }
    }
};
struct EpiBiasBf16 {
    static constexpr bool PERM = true, AFTER_DRAIN = false;
    bf16_t* O; int ldc; const float* bias;
    __device__ __forceinline__ void operator()(const f32x4 (&acc)[2][2][4][2], const Unit& u, int wr, int wc, int fr, int fq) const {
        const int row0 = u.orow + wr * 64 + fr, col0 = u.pn * BM + wc * 32 + 8 * fq; const float* bb = bias + (size_t)u.e * ldc + col0;
        f32x4 bv[2][2];
#pragma unroll
        for (int bj = 0; bj < 2; ++bj)
#pragma unroll
            for (int n = 0; n < 2; ++n) bv[bj][n] = *(const f32x4*)(bb + bj * HALF + 4 * n);
#pragma unroll
        for (int ai = 0; ai < 2; ++ai)
#pragma unroll
            for (int m = 0; m < 4; ++m) { bf16_t* rowp = O + (size_t)(row0 + ai * HALF + m * 16) * ldc + col0;
#pragma unroll
                for (int bj = 0; bj < 2; ++bj) { const f32x4 v0 = acc[ai][bj][m][0] * FP8_WINV + bv[bj][0], v1 = acc[ai][bj][m][1] * FP8_WINV + bv[bj][1];
                    u32x4 w; w.x = cvt_pk_bf16(v0[0], v0[1]); w.y = cvt_pk_bf16(v0[2], v0[3]); w.z = cvt_pk_bf16(v1[0], v1[1]); w.w = cvt_pk_bf16(v1[2], v1[3]);
                    *(u32x4*)(rowp + bj * HALF) = w; } }
    }
};

template <class Epi, class Sched, bool ALIGN_EPI = false, bool SP2 = true, bool FP8 = false>
__device__ __forceinline__ void gemm_phase(PG8_LAS unsigned char* lds, const Gemm g, const Sched& S, const Epi& E) {
    const int tid = threadIdx.x, wid = __builtin_amdgcn_readfirstlane(tid >> 6), lane = tid & 63, wr = wid >> 2, wc = wid & 3, fr = lane & 15, fq = lane >> 4;
    const int KB = g.KB, nt = KB / (BK * 2);
    unsigned voffB[2]; int RA[2], CA[2];
#pragma unroll
    for (int i = 0; i < 2; ++i) { int R, C; stage_rc(tid * 16 + i * 8192, R, C); const int Rb = Epi::PERM ? ((R & ~31) + perm32(R & 31)) : R;
        RA[i] = R; CA[i] = C; voffB[i] = (unsigned)(Rb * KB + C * 2); }
    unsigned cvA[2][2], nvA[2][2];
    const size_t kstep = (size_t)(BK * 2);
    const size_t hstep = (size_t)HALF * KB;
    const size_t tstep = 2 * hstep;
    const unsigned ldsw = (unsigned)wid * 1024u;
    const int aoff = lds_byte(wr * 64 + fr, fq * 8), boff = lds_byte(wc * 32 + fr, fq * 8);
#define PG8_SA(b, h) (((b) * 2 + (h)) * HTB)
#define PG8_SB(b, h) ((4 + (b) * 2 + (h)) * HTB)
#define PG8_STAGE(bufoff, gbase, voff) do { _Pragma("unroll") for (int _i = 0; _i < 2; ++_i) \
        __builtin_amdgcn_global_load_lds((const unsigned*)((const char*)(gbase) + (voff)[_i]), (PG8_LAS unsigned*)(lds + (bufoff) + ldsw + _i * 8192), 16, 0, 0); } while (0)
#define PG8_LD2(p_) __builtin_shufflevector(__builtin_bit_cast(v4i32, *(const PG8_LAS bf16x8*)(p_)), __builtin_bit_cast(v4i32, *(const PG8_LAS bf16x8*)((p_) + 1024)), 0, 1, 2, 3, 4, 5, 6, 7)
#define PG8_LDA(dst, b, h) do { _Pragma("unroll") for (int m = 0; m < 4; ++m) dst[m] = PG8_LD2(lds + PG8_SA(b, h) + aoff + m * 2048); } while (0)
#define PG8_LDB(dst, b, h) do { _Pragma("unroll") for (int n = 0; n < 2; ++n) dst[n] = PG8_LD2(lds + PG8_SB(b, h) + boff + n * 2048); } while (0)
#define PG8_HALF(v_, k_) __builtin_bit_cast(bf16x8, __builtin_shufflevector(v_, v_, 4 * (k_), 4 * (k_) + 1, 4 * (k_) + 2, 4 * (k_) + 3))
#define PG8_MMA(ai, bj, At, Bt) do { __builtin_amdgcn_s_setprio(1); _Pragma("unroll") for (int m = 0; m < 4; ++m) _Pragma("unroll") for (int n = 0; n < 2; ++n) { \
        if constexpr (FP8) asm volatile("v_mfma_f32_16x16x128_f8f6f4 %0, %1, %2, %0" : "+v"(acc[ai][bj][m][n]) : "v"(Bt[n]), "v"(At[m]));     \
        else { acc[ai][bj][m][n] = __builtin_amdgcn_mfma_f32_16x16x32_bf16(PG8_HALF(Bt[n], 0), PG8_HALF(At[m], 0), acc[ai][bj][m][n], 0, 0, 0); \
               acc[ai][bj][m][n] = __builtin_amdgcn_mfma_f32_16x16x32_bf16(PG8_HALF(Bt[n], 1), PG8_HALF(At[m], 1), acc[ai][bj][m][n], 0, 0, 0); } } \
        __builtin_amdgcn_s_setprio(0); } while (0)
#define PG8_WAIT_V(n) asm volatile("s_waitcnt vmcnt(" #n ")" ::: "memory")
#define PG8_WAIT_L(n) asm volatile("s_waitcnt lgkmcnt(" #n ")" ::: "memory")
#define PG8_BAR __builtin_amdgcn_s_barrier()
#define PG8_SCHED __builtin_amdgcn_sched_barrier(0)
    Unit cur, nxt; int ui = 0;
    if (!S.next(0, cur)) return;
    f32x4 acc[2][2][4][2];
#pragma unroll
    for (int a = 0; a < 2; ++a)
#pragma unroll
        for (int b = 0; b < 2; ++b)
#pragma unroll
            for (int m = 0; m < 4; ++m)
#pragma unroll
                for (int n = 0; n < 2; ++n) acc[a][b][m][n] = (f32x4){0.f, 0.f, 0.f, 0.f};
    v8i32 At[4], B0[2], B1[2];
    const char* cA = S.a_base(g, cur); const char* cB = S.b_base(g, cur);
    S.a_ready(cur);
    S.voff_a(g, cur, RA, CA, cvA);
    if constexpr (SP2) {
        PG8_STAGE(PG8_SB(0, 0), cB, voffB); PG8_STAGE(PG8_SB(0, 1), cB + hstep, voffB); PG8_STAGE(PG8_SA(0, 0), cA, cvA[0]); PG8_STAGE(PG8_SA(0, 1), cA, cvA[1]);
        if (wr == 1) PG8_BAR;
        PG8_WAIT_V(2); PG8_BAR;
        PG8_STAGE(PG8_SB(1, 0), cB + kstep, voffB); PG8_STAGE(PG8_SA(1, 0), cA + kstep, cvA[0]); PG8_STAGE(PG8_SB(1, 1), cB + hstep + kstep, voffB);
        PG8_WAIT_V(6); PG8_BAR;
    } else {
        PG8_STAGE(PG8_SB(0, 0), cB, voffB); PG8_STAGE(PG8_SA(0, 0), cA, cvA[0]); PG8_STAGE(PG8_SB(0, 1), cB + hstep, voffB); PG8_STAGE(PG8_SA(0, 1), cA, cvA[1]);
        if (wr == 1) PG8_BAR;
        PG8_WAIT_V(4); PG8_BAR;
        PG8_STAGE(PG8_SB(1, 0), cB + kstep, voffB); PG8_STAGE(PG8_SA(1, 0), cA + kstep, cvA[0]); PG8_STAGE(PG8_SB(1, 1), cB + hstep + kstep, voffB);
        PG8_WAIT_V(6); PG8_BAR;
    }
    for (;;) {
        const bool has_next = S.next(ui + 1, nxt);
        const char* nA = has_next ? S.a_base(g, nxt) : cA; const char* nB = has_next ? S.b_base(g, nxt) : cB;
        if (has_next) S.voff_a(g, nxt, RA, CA, nvA); else { nvA[0][0] = cvA[0][0]; nvA[0][1] = cvA[0][1]; nvA[1][0] = cvA[1][0]; nvA[1][1] = cvA[1][1]; }
#pragma unroll 1
        for (int t = 0; t < nt; t += 2) {
            const bool last = (t == nt - 2);
            const char* a1 = cA + (size_t)(t + 1) * kstep;
            const char* a2 = last ? nA : cA + (size_t)(t + 2) * kstep; const char* b2 = last ? nB : cB + (size_t)(t + 2) * kstep;
            const char* a3 = a2 + kstep; const char* b3 = b2 + kstep;
            unsigned xA0[2], xA1[2];
            xA0[0] = last ? nvA[0][0] : cvA[0][0]; xA0[1] = last ? nvA[0][1] : cvA[0][1]; xA1[0] = last ? nvA[1][0] : cvA[1][0]; xA1[1] = last ? nvA[1][1] : cvA[1][1];
            if (last && has_next) S.a_ready(nxt);
            if constexpr (SP2) {
            PG8_LDB(B0, 0, 0); PG8_LDB(B1, 0, 1); PG8_SCHED; PG8_LDA(At, 0, 0); PG8_STAGE(PG8_SA(1, 1), a1, cvA[1]);
            PG8_WAIT_V(8); PG8_WAIT_L(0); PG8_BAR; PG8_MMA(0, 0, At, B0); PG8_MMA(0, 1, At, B1); PG8_BAR; PG8_SCHED;
            PG8_LDA(At, 0, 1); PG8_STAGE(PG8_SB(0, 0), b2, voffB); PG8_STAGE(PG8_SB(0, 1), b2 + hstep, voffB); PG8_STAGE(PG8_SA(0, 0), a2, xA0);
            PG8_WAIT_V(8); PG8_WAIT_L(0); PG8_BAR; PG8_MMA(1, 0, At, B0); PG8_MMA(1, 1, At, B1); PG8_BAR; PG8_SCHED;
            PG8_LDB(B0, 1, 0); PG8_LDB(B1, 1, 1); PG8_SCHED; PG8_LDA(At, 1, 0); PG8_STAGE(PG8_SA(0, 1), a2, xA1);
            PG8_WAIT_V(8); PG8_WAIT_L(0); PG8_BAR; PG8_MMA(0, 0, At, B0); PG8_MMA(0, 1, At, B1); PG8_BAR; PG8_SCHED;
            PG8_LDA(At, 1, 1); PG8_STAGE(PG8_SB(1, 0), b3, voffB); PG8_STAGE(PG8_SB(1, 1), b3 + hstep, voffB); PG8_STAGE(PG8_SA(1, 0), a3, xA0);
            PG8_WAIT_V(8); PG8_WAIT_L(0); PG8_BAR; PG8_MMA(1, 0, At, B0); PG8_MMA(1, 1, At, B1); PG8_BAR; PG8_SCHED;
            } else {
            PG8_LDB(B0, 0, 0); PG8_SCHED; PG8_LDA(At, 0, 0); PG8_STAGE(PG8_SA(1, 1), a1, cvA[1]);
            PG8_WAIT_L(8); PG8_BAR; PG8_WAIT_L(0); PG8_MMA(0, 0, At, B0); PG8_BAR; PG8_SCHED;
            PG8_LDB(B1, 0, 1); PG8_STAGE(PG8_SB(0, 0), b2, voffB);
            PG8_BAR; PG8_WAIT_L(0); PG8_MMA(0, 1, At, B1); PG8_BAR;
            PG8_LDA(At, 0, 1); PG8_STAGE(PG8_SA(0, 0), a2, xA0);
            PG8_BAR; PG8_WAIT_L(0); PG8_MMA(1, 0, At, B0); PG8_BAR; PG8_SCHED;
            PG8_STAGE(PG8_SB(0, 1), b2 + hstep, voffB);
            PG8_WAIT_V(6); PG8_BAR; PG8_MMA(1, 1, At, B1); PG8_BAR;
            PG8_LDB(B0, 1, 0); PG8_SCHED; PG8_LDA(At, 1, 0); PG8_STAGE(PG8_SA(0, 1), a2, xA1);
            PG8_WAIT_L(8); PG8_BAR; PG8_WAIT_L(0); PG8_MMA(0, 0, At, B0); PG8_BAR; PG8_SCHED;
            PG8_LDB(B1, 1, 1); PG8_STAGE(PG8_SB(1, 0), b3, voffB);
            PG8_BAR; PG8_WAIT_L(0); PG8_MMA(0, 1, At, B1); PG8_BAR;
            PG8_LDA(At, 1, 1); PG8_STAGE(PG8_SA(1, 0), a3, xA0);
            PG8_BAR; PG8_WAIT_L(0); PG8_MMA(1, 0, At, B0); PG8_BAR; PG8_SCHED;
            PG8_STAGE(PG8_SB(1, 1), b3 + hstep, voffB);
            PG8_WAIT_V(6); PG8_BAR; PG8_MMA(1, 1, At, B1); PG8_BAR;
            }
        }
        if constexpr (FP8) asm volatile("s_nop 15\n\ts_nop 7" ::: "memory");
        if constexpr (ALIGN_EPI) { if (wr == 0) PG8_BAR; }
        if constexpr (!Epi::AFTER_DRAIN) { E(acc, cur, wr, wc, fr, fq); S.done(cur); }
        if (!has_next) break;
#pragma unroll
        for (int a = 0; a < 2; ++a)
#pragma unroll
            for (int b = 0; b < 2; ++b)
#pragma unroll
                for (int m = 0; m < 4; ++m)
#pragma unroll
                    for (int n = 0; n < 2; ++n) acc[a][b][m][n] = (f32x4){0.f, 0.f, 0.f, 0.f};
        cur = nxt; cA = nA; cB = nB; ++ui; cvA[0][0] = nvA[0][0]; cvA[0][1] = nvA[0][1]; cvA[1][0] = nvA[1][0]; cvA[1][1] = nvA[1][1];
        if constexpr (ALIGN_EPI) { if (wr == 1) PG8_BAR; }
    }
    PG8_WAIT_V(0);
    if constexpr (!ALIGN_EPI) { if (wr == 0) PG8_BAR; }
    PG8_BAR;
    if constexpr (Epi::AFTER_DRAIN) { E.fused(acc, cur, wr, wc, fr, fq, lds, wid, lane); S.done(cur); }
#undef PG8_SA
#undef PG8_SB
#undef PG8_STAGE
#undef PG8_LDA
#undef PG8_LD2
#undef PG8_HALF
#undef PG8_LDB
#undef PG8_MMA
#undef PG8_WAIT_V
#undef PG8_WAIT_L
#undef PG8_BAR
#undef PG8_SCHED
}
}

constexpr int NWAVES = 8;
constexpr int BATCH = 2, SEQ = 8192, D = 1024, M = BATCH * SEQ;
constexpr int PROJW = 3096, NPROJ = 3072;
constexpr int FH = 8, GH = 4, NE = 32, TOPK = 4, ECAP = M, NSLOT = M * TOPK + NE * 256;
constexpr float LOG2E = 1.4426950408889634f, C2 = 0.125f * 1.4426950408889634f, EPS = 1e-5f;
constexpr size_t MiB = 1u << 20;
constexpr size_t WS_CTL = 0, CTL_ZERO_BYTES = 1 * MiB;
constexpr size_t WS_TOKL = 2 * MiB;
constexpr size_t WS_PIDX = 4 * MiB, WS_EIDX = WS_PIDX + 256 * 1024, WS_GATE = WS_EIDX + 256 * 1024;
constexpr size_t WS_FLT = 5 * MiB, WS_F2 = WS_FLT + 512 * 1024;
constexpr size_t WS_GLOW = 6 * MiB;
constexpr size_t WS_DECAY = 7 * MiB;
constexpr size_t WS_WIN = 8 * MiB, WS_WOUT = 14 * MiB, WS_E1 = 16 * MiB, WS_E2 = 144 * MiB;
constexpr size_t WS_XN = 208 * MiB;
constexpr size_t WS_P1 = 240 * MiB;
constexpr size_t WS_UPD = 336 * MiB;
constexpr size_t WS_CAT = 368 * MiB;
constexpr size_t WS_H = 400 * MiB;
constexpr size_t WS_ACT = 464 * MiB, WS_Y = 608 * MiB, WS_END = 752 * MiB;
static_assert((size_t)NSLOT * D * 2 <= 144 * MiB, "slot buffers");
constexpr int CW_TMO = 0, CW_CODE = 1, CW_BAR = 4096, CW_ECNT = 8192;
constexpr int CW_QKN = 12288, CW_QUEUE = 16384;
constexpr size_t WS_UTAB = 7 * MiB + 512 * 1024;
constexpr int RING_OFF = 0, RING_BYTES = 131072, EXTRA_OFF = RING_BYTES, EXTRA_BYTES = 28672, LDSCTL_OFF = EXTRA_OFF + EXTRA_BYTES, MISC_OFF = LDSCTL_OFF + 320, LDS_BYTES = 163840;
static_assert(MISC_OFF + 128 <= LDS_BYTES, "LDS map");

#define GAS __attribute__((address_space(1)))
#define LAS __attribute__((address_space(3)))
typedef unsigned short bf16;
typedef unsigned v4u __attribute__((ext_vector_type(4)));
typedef float f32x4 __attribute__((ext_vector_type(4)));
typedef short bf16x8 __attribute__((ext_vector_type(8)));
typedef GAS unsigned gu32;
typedef GAS unsigned long long gu64;
#define RLX_AGENT __ATOMIC_RELAXED, __HIP_MEMORY_SCOPE_AGENT
#define LDS_WAIT() asm volatile("s_waitcnt lgkmcnt(0)" ::: "memory")
#define VM_WAIT() asm volatile("s_waitcnt vmcnt(0)" ::: "memory")
__device__ __forceinline__ unsigned long long rt() { return __builtin_amdgcn_s_memrealtime(); }
__device__ __forceinline__ unsigned f2bf(float f) { unsigned u = __builtin_bit_cast(unsigned, f); return (u + 0x7fffu + ((u >> 16) & 1u)) >> 16; }
__device__ __forceinline__ unsigned pk2(float lo, float hi) { return f2bf(lo) | (f2bf(hi) << 16); }

#define XB_TMO      128
#define XB_XCNT(j)  (256  + 64 * (j))
#define XB_XSUB(j)  (1280 + 64 * (j))
#define XB_XGEN(j)  (2304 + 64 * (j))
#define XB_TOP      3328
#define XB_TOPGEN   3392
#define XCD_BAR_WORDS 3456
#define XB_SPIN_CAP (1u << 18)

__device__ __forceinline__ unsigned xb_ld(unsigned* p)              { return __hip_atomic_load(p, __ATOMIC_RELAXED, __HIP_MEMORY_SCOPE_AGENT); }
__device__ __forceinline__ unsigned xb_add(unsigned* p, unsigned v) { return __hip_atomic_fetch_add(p, v, __ATOMIC_RELAXED, __HIP_MEMORY_SCOPE_AGENT); }
__device__ __forceinline__ unsigned xb_xcc_id() { return (unsigned)__builtin_amdgcn_s_getreg((3 << 11) | 20) & 0xFu; }
#define XB_SPIN(cond, bar) do { unsigned _sp = 0; while (cond) { __builtin_amdgcn_s_sleep(1); \
    if ((++_sp & 255u) == 0u) { if (xb_ld(&(bar)[XB_TMO])) break; if (_sp > XB_SPIN_CAP) { atomicAdd(&(bar)[XB_TMO], 1u); break; } } } } while (0)

struct XcdBarrier {
    unsigned* bar; unsigned x;
    volatile LAS unsigned* st;
};

__device__ __forceinline__ XcdBarrier xcd_barrier_post(unsigned* bar, volatile LAS unsigned* st) {
    XcdBarrier b; b.bar = bar; b.x = xb_xcc_id(); b.st = st;
    if (threadIdx.x == 0) (void)xb_add(&bar[XB_XCNT(b.x)], 1u);
    return b;
}
__device__ __forceinline__ void xcd_barrier_complete(unsigned* bar, unsigned x, unsigned& nloc, unsigned& nx) {
    const unsigned G = gridDim.x * gridDim.y * gridDim.z;
    unsigned sum, cnt, mine, sp = 0u;
    for (;;) {
        sum = 0u; cnt = 0u; mine = 0u;
#pragma unroll
        for (unsigned j = 0; j < 16; ++j) { const unsigned c = xb_ld(&bar[XB_XCNT(j)]); sum += c; cnt += (c > 0u) ? 1u : 0u; mine = (j == x) ? c : mine; }
        if (sum == G) break;
        __builtin_amdgcn_s_sleep(1);
        if ((++sp & 255u) == 0u) { if (xb_ld(&bar[XB_TMO])) break; if (sp > XB_SPIN_CAP) { atomicAdd(&bar[XB_TMO], 1u); break; } }
    }
    nloc = mine > 0u ? mine : 1u; nx = cnt > 0u ? cnt : 1u;
}

__device__ __forceinline__ void xcd_barrier(const XcdBarrier& b) {
    asm volatile("s_waitcnt vmcnt(0)" ::: "memory");
    __syncthreads();
    if (threadIdx.x == 0) {
        unsigned* bar = b.bar;
        __builtin_amdgcn_s_waitcnt(0);
        unsigned nloc = b.st[0], nx = b.st[1];
        if (nloc == 0u) { xcd_barrier_complete(bar, b.x, nloc, nx); b.st[0] = nloc; b.st[1] = nx; }
        const unsigned old = xb_add(&bar[XB_XSUB(b.x)], 1u);
        const unsigned gen = old / nloc;
        if (old + 1u == (gen + 1u) * nloc) {
            __builtin_amdgcn_fence(__ATOMIC_RELEASE, "agent");
            asm volatile("s_waitcnt vmcnt(0)" ::: "memory");
            const unsigned og = xb_add(&bar[XB_TOP], 1u);
            const unsigned tg = og / nx;
            if (og + 1u == (tg + 1u) * nx) xb_add(&bar[XB_TOPGEN], 1u);
            else XB_SPIN(xb_ld(&bar[XB_TOPGEN]) == tg, bar);
            __builtin_amdgcn_fence(__ATOMIC_ACQUIRE, "agent");
            xb_add(&bar[XB_XGEN(b.x)], 1u);
            asm volatile("s_waitcnt vmcnt(0)" ::: "memory");
        } else {
            XB_SPIN(xb_ld(&bar[XB_XGEN(b.x)]) == gen, bar);
            __builtin_amdgcn_fence(__ATOMIC_ACQUIRE, "agent");
            asm volatile("s_waitcnt vmcnt(0)" ::: "memory");
        }
    }
    __syncthreads();
}

struct Frame {
    LAS unsigned char* lds; volatile LAS unsigned* MISC; gu32* ctl;
    int tid, lane, wave, vcu, G;
    const float *x, *n1g, *w_in, *fbias, *gup, *gbias, *gng, *w_out, *n2g, *rw, *rb, *ewi, *ebi, *ewo, *ebo, *fg; float* out; unsigned char* ws;
};
__device__ __forceinline__ float wave_sum(float v) {
#pragma unroll
    for (int o = 1; o < 64; o <<= 1) v += __shfl_xor(v, o);
    return v;
}
__device__ __forceinline__ float log_sigmoid_f(float x) { return fminf(x, 0.f) - log1pf(__expf(-fabsf(x))); }
#define BFLY_STEP(n, m) { const bool up_ = (lane & (m)) != 0; _Pragma("unroll") for (int i_ = 0; i_ < (n) / 2; ++i_) { const float send_ = up_ ? v[i_] : v[i_ + (n) / 2]; const float recv_ = __shfl_xor(send_, (m)); \
        const float keep_ = up_ ? v[i_ + (n) / 2] : v[i_]; v[i_] = keep_ + recv_; } }
__device__ __forceinline__ float bfly32(float (&v)[32], int lane) { BFLY_STEP(32, 32) BFLY_STEP(16, 16) BFLY_STEP(8, 8) BFLY_STEP(4, 4) BFLY_STEP(2, 2) return v[0] + __shfl_xor(v[0], 1); }

__device__ __forceinline__ void p0_transpose_blk(const float* W, int ld, int k0, int c0, bf16* WT, int K, int r0, LAS float* scr, int lane) {
#pragma unroll 8
    for (int i = 0; i < 32; ++i) { const int kk = 2 * i + (lane >> 5); scr[kk * 33 + (lane & 31)] = W[(size_t)(k0 + kk) * ld + c0 + (lane & 31)]; }
    LDS_WAIT(); asm volatile("" ::: "memory");
    const int c = lane & 7;
#pragma unroll
    for (int j = 0; j < 4; ++j) { const int n = (lane >> 3) + 8 * j; const LAS float* s = scr + (8 * c) * 33 + n;
        v4u o; o.x = pk2(s[0 * 33], s[1 * 33]); o.y = pk2(s[2 * 33], s[3 * 33]); o.z = pk2(s[4 * 33], s[5 * 33]); o.w = pk2(s[6 * 33], s[7 * 33]);
        *(GAS v4u*)(WT + (size_t)(r0 + n) * K + k0 + 8 * c) = o; }
    LDS_WAIT(); asm volatile("" ::: "memory");
}
constexpr int W24_LD = 1032;
__device__ __forceinline__ void p0_row(Frame& F, int m, const LAS float* w24, const f32x4 (&gv)[4], bf16* XN, float* FLT, float* GLOW) {
    int lane = F.lane; asm volatile("" : "+v"(lane));
    const GAS f32x4* xr = (const GAS f32x4*)(F.x + (size_t)m * D) + lane;
    f32x4 v[4]; float s = 0.f;
#pragma unroll
    for (int j = 0; j < 4; ++j) { v[j] = xr[64 * j]; s += (v[j].x * v[j].x + v[j].y * v[j].y) + (v[j].z * v[j].z + v[j].w * v[j].w); }
    const float rstd = 1.f / sqrtf(wave_sum(s) * (1.f / D) + EPS);
    GAS unsigned long long* o8 = (GAS unsigned long long*)(XN + (size_t)m * D) + lane;
#pragma unroll
    for (int j = 0; j < 4; ++j) { v[j] = v[j] * rstd * gv[j]; o8[64 * j] = (unsigned long long)pk2(v[j].x, v[j].y) | ((unsigned long long)pk2(v[j].z, v[j].w) << 32); }
    float a[32];
#pragma unroll
    for (int c = 0; c < 24; ++c) { float t = 0.f;
#pragma unroll
        for (int j = 0; j < 4; ++j) { const f32x4 w = *(const LAS f32x4*)(w24 + c * W24_LD + 256 * j + 4 * lane); t += (v[j].x * w.x + v[j].y * w.y) + (v[j].z * w.z + v[j].w * w.w); }
        a[c] = t; if ((c & 3) == 3) asm volatile("" ::: "memory"); }
#pragma unroll
    for (int c = 24; c < 32; ++c) a[c] = 0.f;
    const float tot = bfly32(a, lane);
    const int idx = lane >> 1;
    if ((lane & 1) == 0) {
        if (idx < 8) FLT[(size_t)idx * M + m] = log_sigmoid_f(tot + F.fbias[idx]) * LOG2E;
        else if (idx < 24) GLOW[(size_t)m * 16 + (idx - 8)] = tot;
    }
}
__device__ __forceinline__ void p0_prologue(Frame& F) {
    const int gw = F.vcu * NWAVES + F.wave, NGW = F.G * NWAVES, tid = F.tid;
    bf16* XN = (bf16*)(F.ws + WS_XN); float* FLT = (float*)(F.ws + WS_FLT); float* GLOW = (float*)(F.ws + WS_GLOW);
    LAS float* w24 = (LAS float*)(F.lds + RING_OFF);
    __syncthreads();
    for (int it = 0; it < 16; ++it) { const int i = tid + 512 * it, k = i >> 3, c = i & 7; w24[c * W24_LD + k] = F.w_in[(size_t)k * PROJW + 1536 + c]; }
    for (int it = 0; it < 32; ++it) { const int i = tid + 512 * it, k = i >> 4, c = i & 15; w24[(8 + c) * W24_LD + k] = F.w_in[(size_t)k * PROJW + 2568 + c]; }
    __syncthreads();
    { f32x4 gv[4]; int lane_ = F.lane; asm volatile("" : "+v"(lane_));
#pragma unroll
      for (int j = 0; j < 4; ++j) gv[j] = ((const GAS f32x4*)F.n1g)[lane_ + 64 * j];
      for (int m = gw; m < M; m += NGW) p0_row(F, m, w24, gv, XN, FLT, GLOW); }
    __syncthreads();
    LAS float* scr = (LAS float*)(F.lds + RING_OFF + F.wave * 16384);
    bf16* WIN = (bf16*)(F.ws + WS_WIN); bf16* WOUT = (bf16*)(F.ws + WS_WOUT);
    constexpr int I_IN = 16 * 96, I_OUT = 16 * 32, NITEMS = I_IN + I_OUT;
    for (int it = gw; it < NITEMS; it += NGW) {
        int r = it;
        if (r < I_IN) { const int kb = r / 96, nb = r % 96, r0 = 32 * nb, c0 = r0 + (r0 < 1536 ? 0 : (r0 < 2560 ? 8 : 24)); p0_transpose_blk(F.w_in, PROJW, 64 * kb, c0, WIN, D, r0, scr, F.lane); continue; } r -= I_IN;
        { const int kb = r / 32, nb = r % 32; p0_transpose_blk(F.w_out, D, 64 * kb, 32 * nb, WOUT, D, 32 * nb, scr, F.lane); }
    }
}
constexpr int CONV_I_E1 = 16 * 64, CONV_I_E2 = 16 * 32, CONV_BATCHES = NE * (CONV_I_E1 + CONV_I_E2) / 32;
struct ConvBlk { const float* src; unsigned char* dst; int ld; };
__device__ __forceinline__ ConvBlk conv_blk(Frame& F, int r) {
    ConvBlk b;
    if (r < NE * CONV_I_E1) { const int e = r / CONV_I_E1, q = r % CONV_I_E1, kb = q / 64, nb = q % 64, r0 = 32 * nb, within = r0 & 255, c0 = (within >> 7) * 1024 + (r0 >> 8) * 128 + (within & 127);
        b.src = F.ewi + (size_t)e * D * 2048 + (size_t)(64 * kb) * 2048 + c0; b.dst = F.ws + WS_E1 + (size_t)e * 2048 * D + (size_t)r0 * D + 64 * kb; b.ld = 2048; }
    else { r -= NE * CONV_I_E1; const int e = r / CONV_I_E2, q = r % CONV_I_E2, kb = q / 32, nb = q % 32;
        b.src = F.ewo + (size_t)e * D * D + (size_t)(64 * kb) * D + 32 * nb; b.dst = F.ws + WS_E2 + (size_t)e * D * D + (size_t)(32 * nb) * D + 64 * kb; b.ld = D; }
    return b;
}
__device__ __forceinline__ void conv_load(const ConvBlk& b, int lane, f32x4 (&v)[8]) {
#pragma unroll
    for (int i = 0; i < 8; ++i) v[i] = __builtin_nontemporal_load((const f32x4*)(b.src + (size_t)(8 * i + (lane >> 3)) * b.ld + 4 * (lane & 7)));
}
__device__ __forceinline__ void conv_batch(Frame& F, int batch) {
    LAS float* scr = (LAS float*)(F.lds + RING_OFF + F.wave * 16384); const int lane = F.lane;
    f32x4 v[8]; ConvBlk cur = conv_blk(F, batch * 32 + F.wave * 4);
    conv_load(cur, lane, v);
#pragma unroll 1
    for (int j = 0; j < 4; ++j) {
#pragma unroll
        for (int i = 0; i < 8; ++i) *(LAS f32x4*)(scr + (8 * i + (lane >> 3)) * 32 + 4 * (((lane & 7) + i) & 7)) = v[i];
        const ConvBlk nxt = conv_blk(F, batch * 32 + F.wave * 4 + (j < 3 ? j + 1 : j));
        if (j < 3) conv_load(nxt, lane, v);
        LDS_WAIT(); asm volatile("" ::: "memory");
        const int c = lane & 7;
#pragma unroll
        for (int jj = 0; jj < 4; ++jj) { const int n = (lane >> 3) + 8 * jj; const LAS float* sp = scr + (8 * c) * 32 + 4 * (((n >> 2) + c) & 7) + (n & 3);
            pg8::u32x2 o; o.x = pg8::pk4_fp8(sp[0 * 32] * 32.f, sp[1 * 32] * 32.f, sp[2 * 32] * 32.f, sp[3 * 32] * 32.f); o.y = pg8::pk4_fp8(sp[4 * 32] * 32.f, sp[5 * 32] * 32.f, sp[6 * 32] * 32.f, sp[7 * 32] * 32.f);
            *(GAS pg8::u32x2*)(cur.dst + (size_t)n * D + 8 * c) = o; }
        LDS_WAIT(); asm volatile("" ::: "memory");
        cur = nxt;
    }
    __syncthreads();
}

#include <hip/hip_bf16.h>
#include <cmath>
namespace attn_body {
using bf16=__hip_bfloat16;
using bf16x8=__attribute__((ext_vector_type(8)))short;
using s16x4=__attribute__((ext_vector_type(4)))short;
using f32x16=__attribute__((ext_vector_type(16)))float;
using u32x4=__attribute__((ext_vector_type(4)))unsigned;
constexpr int BATCH=2,NHEAD=8,SEQ=8192,D=64,DM=NHEAD*D,OPITCH=1024;
constexpr int NW=8,QBLK=32,QB=QBLK*NW,KVBLK=64,NQB=SEQ/QB;
constexpr int ATTN_PITCH=DM, ATTN_UNIT_ROWS=QB;
__device__ __forceinline__ int crow(int r,int hi){return (r&3)+8*(r>>2)+4*hi;}
#define SBAR() __builtin_amdgcn_sched_barrier(0)
__device__ __forceinline__ void cmask(f32x16&p0,f32x16&p1,int jb,int qrel,int hi){
  const float NEG=-INFINITY; int kb=64*jb+4*hi;
  #pragma unroll
  for(int r=0;r<16;++r){int kv=kb+(r&3)+8*(r>>2); if(kv>qrel)p0[r]=NEG; if(kv+32>qrel)p1[r]=NEG;}
}

constexpr int NSLOT=3, SLOTB=8192;
constexpr int LDS_K=0, LDS_V=NSLOT*SLOTB, LDS_WS=2*NSLOT*SLOTB, LDS_OST=LDS_WS+NW*64*4, LDS_F=LDS_OST+NW*4096, LDS_BYTES=LDS_F+SEQ*4;
constexpr float C2=0.125f*1.4426950408889634f;
__device__ __forceinline__ void glds16(const void*gsrc,unsigned lds_dst){unsigned keep;
  asm volatile("s_mov_b32 %0, m0\n\ts_mov_b32 m0, %2\n\ts_nop 0\n\tglobal_load_lds_dwordx4 %1, off\n\ts_mov_b32 m0, %0":"=&s"(keep):"v"(gsrc),"s"(lds_dst):"memory");}
__device__ __forceinline__ float max3f(float a,float b,float c){float r;asm("v_max3_f32 %0, %1, %2, %3":"=v"(r):"v"(a),"v"(b),"v"(c));return r;}
__device__ __forceinline__ float max2f(float a,float b){float r;asm("v_max_f32_e32 %0, %1, %2":"=v"(r):"v"(a),"v"(b));return r;}
__device__ __forceinline__ float fadd_s(float a,float b){float r;asm("v_add_f32_e32 %0, %1, %2":"=v"(r):"v"(a),"v"(b));return r;}
__device__ __forceinline__ float fsub_s(float a,float b){float r;asm("v_sub_f32_e32 %0, %1, %2":"=v"(r):"v"(a),"v"(b));return r;}
typedef float f32x2_t __attribute__((ext_vector_type(2))); typedef __bf16 bf16x2_t __attribute__((ext_vector_type(2)));
__device__ __forceinline__ unsigned cvtpk_s(float lo,float hi){f32x2_t v={lo,hi};bf16x2_t b=__builtin_convertvector(v,bf16x2_t);return __builtin_bit_cast(unsigned,b);}
#define WAIT_BAR(N) asm volatile("s_waitcnt vmcnt(" #N ") lgkmcnt(0)\n\ts_barrier":::"memory")

__device__ __forceinline__ void qkt(f32x16&p0,f32x16&p1,const char*Kslot,const bf16x8*qr,int r32,int hi){
  const char*kb=Kslot+hi*1024+r32*16;
  #pragma unroll
  for(int d0=0;d0<4;++d0){
    const bf16x8 b0=*reinterpret_cast<const bf16x8*>(kb+d0*2048);
    const bf16x8 b1=*reinterpret_cast<const bf16x8*>(kb+d0*2048+512);
    p0=__builtin_amdgcn_mfma_f32_32x32x16_bf16(b0,qr[d0],p0,0,0,0);p1=__builtin_amdgcn_mfma_f32_32x32x16_bf16(b1,qr[d0],p1,0,0,0);}
}
typedef __attribute__((address_space(3))) const char* lds_cptr;
typedef short v4i16_t __attribute__((ext_vector_type(4)));
__device__ __forceinline__ void kload8(bf16x8*kf,lds_cptr kp){
  kf[0]=*(const __attribute__((address_space(3))) bf16x8*)(kp);      kf[1]=*(const __attribute__((address_space(3))) bf16x8*)(kp+512);
  kf[2]=*(const __attribute__((address_space(3))) bf16x8*)(kp+2048); kf[3]=*(const __attribute__((address_space(3))) bf16x8*)(kp+2560);
  kf[4]=*(const __attribute__((address_space(3))) bf16x8*)(kp+4096); kf[5]=*(const __attribute__((address_space(3))) bf16x8*)(kp+4608);
  kf[6]=*(const __attribute__((address_space(3))) bf16x8*)(kp+6144); kf[7]=*(const __attribute__((address_space(3))) bf16x8*)(kp+6656);
}
__device__ __forceinline__ void kload2(bf16x8*kf,lds_cptr kp,int j){ kf[2*j]=*(const __attribute__((address_space(3))) bf16x8*)(kp+j*2048); kf[2*j+1]=*(const __attribute__((address_space(3))) bf16x8*)(kp+j*2048+512); }
typedef float f32x4_t __attribute__((ext_vector_type(4)));
__device__ __forceinline__ void fkinit(f32x16&c0,f32x16&c1,lds_cptr fp,float qoff){
  #pragma unroll
  for(int g=0;g<4;++g){ const f32x4_t a=*(const __attribute__((address_space(3))) f32x4_t*)(fp+g*32); const f32x4_t b=*(const __attribute__((address_space(3))) f32x4_t*)(fp+128+g*32);
    #pragma unroll
    for(int i=0;i<4;++i){ c0[4*g+i]=qoff-a[i]; c1[4*g+i]=qoff-b[i]; } }
}
__device__ __forceinline__ s16x4 vtr(lds_cptr p){ return __builtin_bit_cast(s16x4,__builtin_amdgcn_ds_read_tr16_b64_v4i16((__attribute__((address_space(3))) v4i16_t*)p)); }
__device__ __forceinline__ float rowmax(const f32x16&p0,const f32x16&p1){
  float a=max3f(p0[0],p0[1],p1[0]),b=max3f(p0[2],p0[3],p1[1]);a=max3f(a,p1[2],p1[3]);
  #pragma unroll
  for(int r=4;r<16;r+=4){a=max3f(a,p0[r],p0[r+1]);b=max3f(b,p0[r+2],p0[r+3]);a=max3f(a,p1[r],p1[r+1]);b=max3f(b,p1[r+2],p1[r+3]);}
  const float m=max2f(a,b);
  auto rr=__builtin_amdgcn_permlane32_swap(__float_as_uint(m),__float_as_uint(m),false,false);
  return max2f(__uint_as_float(rr[0]),__uint_as_float(rr[1]));
}
__device__ __forceinline__ void pv(f32x16*o,int vb,bf16x8 pa0,bf16x8 pa1,bf16x8 pa2,bf16x8 pa3){
  #pragma unroll
  for(int d0=0;d0<2;++d0){s16x4 lo[4],hi[4];
    #pragma unroll
    for(int ks=0;ks<4;++ks){
      asm volatile("ds_read_b64_tr_b16 %0,%1 offset:%c2":"=&v"(lo[ks]):"v"(vb),"i"(d0*4096+ks*1024):"memory");
      asm volatile("ds_read_b64_tr_b16 %0,%1 offset:%c2":"=&v"(hi[ks]):"v"(vb),"i"(d0*4096+ks*1024+512):"memory");}
    asm volatile("s_waitcnt lgkmcnt(0)":::"memory");SBAR();
    #define PK(k) (bf16x8){lo[k][0],lo[k][1],lo[k][2],lo[k][3],hi[k][0],hi[k][1],hi[k][2],hi[k][3]}
    o[d0]=__builtin_amdgcn_mfma_f32_32x32x16_bf16(pa0,PK(0),o[d0],0,0,0);
    o[d0]=__builtin_amdgcn_mfma_f32_32x32x16_bf16(pa1,PK(1),o[d0],0,0,0);
    o[d0]=__builtin_amdgcn_mfma_f32_32x32x16_bf16(pa2,PK(2),o[d0],0,0,0);
    o[d0]=__builtin_amdgcn_mfma_f32_32x32x16_bf16(pa3,PK(3),o[d0],0,0,0);
    #undef PK
  }
}

#ifndef ATTN_STORE16
#define ATTN_STORE16(p,v) (*(u32x4*)(p)=(v))
#endif
template<int THRL> __device__ __forceinline__ void attn_unit(int b,int h,int qb,int T0,const bf16*Q,const bf16*__restrict__ K,const bf16*__restrict__ V,const float*__restrict__ F2,bf16*O,char*shm){
  const int tid=threadIdx.x,lane=tid&63,r32=lane&31,hi=lane>>5; const int wid=__builtin_amdgcn_readfirstlane(tid>>6);
  const long rowbase=(long)b*SEQ; const int q0=qb*QB;
  const bf16*Qw=Q+(rowbase+q0+wid*QBLK)*DM+h*D;
  const bf16*Kh=K+(rowbase+(long)T0*KVBLK)*DM+h*D,*Vh=V+(rowbase+(long)T0*KVBLK)*DM+h*D;
  const unsigned lds0=(unsigned)(uintptr_t)shm;
  float*wsf=(float*)(shm+LDS_WS)+wid*64;
  const bf16*ksrc=Kh+(long)lane*DM+wid*8;
  const bf16*vsrc=Vh+(long)(16*(wid&3)+(lane>>2))*DM+(wid>>2)*32+(lane&3)*8;
  const unsigned kdst=lds0+LDS_K+wid*1024, vdst=lds0+LDS_V+wid*1024;
  #define DMA_K(t,slot) glds16(ksrc+(long)(t)*KVBLK*DM,(unsigned)__builtin_amdgcn_readfirstlane(kdst+(slot)))
  #define DMA_V(t,slot) glds16(vsrc+(long)(t)*KVBLK*DM,(unsigned)__builtin_amdgcn_readfirstlane(vdst+(slot)))
  const int vb0=(int)(lds0+LDS_V)+((lane>>4)&1)*32+(lane&3)*8+(4*hi+((lane&15)>>2))*64;
  const char*Kbase=shm+LDS_K; bf16x8 kf[8];
  const lds_cptr shm3=(lds_cptr)shm; const lds_cptr kp0=shm3+LDS_K+hi*1024+r32*16; const lds_cptr vp0=shm3+LDS_V+((lane>>4)&1)*32+(lane&3)*8+(4*hi+((lane&15)>>2))*64;
  const int NT=(q0+QB)/KVBLK-T0;
  const float*F2h=F2+(long)(b*NHEAD+h)*SEQ;
  for(int p_=wid;p_<((NT+3)>>2);p_+=NW) glds16(F2h+T0*KVBLK+p_*256+lane*4,(unsigned)__builtin_amdgcn_readfirstlane(lds0+LDS_F+p_*1024));
  const lds_cptr fp0=shm3+LDS_F+hi*16;
  DMA_K(0,0);DMA_V(0,0);DMA_K(1,SLOTB);
  bf16x8 qr[4];
  #pragma unroll
  for(int d0=0;d0<4;++d0)qr[d0]=*reinterpret_cast<const bf16x8*>(&Qw[(long)r32*DM+d0*16+hi*8]);
  const float F2q=F2h[q0+wid*QBLK+r32]; float mhat=0.f,l_reg=0.f,qoff=F2q;f32x16 o[2];o[0]=f32x16{};o[1]=f32x16{};
  const int qrel=wid*QBLK+r32;
  #define CMASK(P0,P1,t) do{int jb_=(t)-(NT-4); if(jb_>=0)cmask(P0,P1,jb_,qrel,hi);}while(0)
  bool resc=false;
  #define START(P0,P1) do{ const float rm=rowmax(P0,P1); resc=false; \
    { const float dl=rm; mhat=fadd_s(mhat,dl); \
      _Pragma("unroll") for(int r=0;r<16;++r){P0[r]=fsub_s(P0[r],dl);P1[r]=fsub_s(P1[r],dl);} \
      qoff=F2q-mhat; } \
    _Pragma("unroll") for(int r=0;r<16;++r)P0[r]=__builtin_amdgcn_exp2f(P0[r]); }while(0)
  #define RESC() do{ if(resc){ asm volatile("s_waitcnt lgkmcnt(0)":::"memory"); \
      _Pragma("unroll") for(int d_=0;d_<2;++d_) _Pragma("unroll") for(int r=0;r<16;++r)o[d_][r]*=wsf[crow(r,hi)]; } }while(0)
  f32x16 pA0,pA1,pB0,pB1;
  int sl_prev=0,sl_cur=0,sl_next=SLOTB;
  #define ROT() do{sl_prev=sl_cur;sl_cur=sl_next;sl_next=(sl_next==(NSLOT-1)*SLOTB)?0:sl_next+SLOTB;}while(0)
  DMA_K(2,2*SLOTB);
  WAIT_BAR(3);
  fkinit(pA0,pA1,fp0,qoff); qkt(pA0,pA1,Kbase,qr,r32,hi);asm volatile("s_nop 15\n\ts_nop 7":"+v"(pA0),"+v"(pA1));CMASK(pA0,pA1,0);
  START(pA0,pA1);
  _Pragma("unroll") for(int r=0;r<16;++r)pA1[r]=__builtin_amdgcn_exp2f(pA1[r]);
  WAIT_BAR(0);
  DMA_K(3,0);DMA_V(1,SLOTB);
  ROT();
  kload8(kf,kp0+sl_cur);
  WAIT_BAR(2);
  s16x4 vlo[8],vhi[8]; u32x4 pw0,pw1,pw2,pw3;
  #define PKW(P,B) cvtpk_s(P[B],P[B+1])
  #define PAF(k) __builtin_bit_cast(bf16x8,pw##k)
  #define VFR(i) (bf16x8){vlo[i][0],vlo[i][1],vlo[i][2],vlo[i][3],vhi[i][0],vhi[i][1],vhi[i][2],vhi[i][3]}
  #define PIN(x) asm volatile("":"+v"(x))
  #define MX3(a,b,c) __builtin_fmaxf(__builtin_fmaxf((a),(b)),(c))
  #define GAPA(MF,A0,A1,A2,A3,W0,W1,PW) do{ MF; sacc+=A0; sacc+=A1; sacc+=A2; sacc+=A3; PIN(sacc); W0; W1; PIN(PW); SBAR(); }while(0)
  #define EX(v) __builtin_amdgcn_exp2f(v)
  #define GAPB(MF,X,B) do{ MF; X[B]=EX(X[B]); X[B+1]=EX(X[B+1]); X[B+2]=EX(X[B+2]); X[B+3]=EX(X[B+3]); PIN(X); SBAR(); }while(0)
  #define VRD(i) do{ vlo[i]=vtr(vp_+(((i)>>2)*4096+((i)&3)*1024)); vhi[i]=vtr(vp_+(((i)>>2)*4096+((i)&3)*1024+512)); }while(0)
  #define KRD(G,j) do{ if(G){ kload2(kf,kp0+sl_next,j); SBAR(); } }while(0)
  #define STEP(C0,C1,P0,P1,t,GK,GV,GL) do{ SBAR(); \
    fkinit(C0,C1,fp0+(t)*256,qoff); SBAR(); \
    const lds_cptr vp_=vp0+sl_prev; \
    VRD(0); SBAR(); float sacc=(P0[0]+P0[1]); \
    GAPA(C0=__builtin_amdgcn_mfma_f32_32x32x16_bf16(kf[0],qr[0],C0,0,0,0), P0[2],P0[3],P0[4],P0[5],     pw0[0]=PKW(P0,0), pw0[1]=PKW(P0,2), pw0); \
    VRD(4); SBAR(); GAPA(C1=__builtin_amdgcn_mfma_f32_32x32x16_bf16(kf[1],qr[0],C1,0,0,0), P0[6],P0[7],P0[8],P0[9],     pw0[2]=PKW(P0,4), pw0[3]=PKW(P0,6), pw0); \
    VRD(1); SBAR(); GAPA(C0=__builtin_amdgcn_mfma_f32_32x32x16_bf16(kf[2],qr[1],C0,0,0,0),   P0[10],P0[11],P0[12],P0[13], pw1[0]=PKW(P0,8), pw1[1]=PKW(P0,10), pw1); \
    VRD(5); SBAR(); GAPA(C1=__builtin_amdgcn_mfma_f32_32x32x16_bf16(kf[3],qr[1],C1,0,0,0),   P0[14],P0[15],P1[0],P1[1],   pw1[2]=PKW(P0,12),pw1[3]=PKW(P0,14), pw1); \
    VRD(2); SBAR(); GAPA(C0=__builtin_amdgcn_mfma_f32_32x32x16_bf16(kf[4],qr[2],C0,0,0,0),   P1[2],P1[3],P1[4],P1[5],     pw2[0]=PKW(P1,0), pw2[1]=PKW(P1,2), pw2); \
    VRD(6); SBAR(); GAPA(C1=__builtin_amdgcn_mfma_f32_32x32x16_bf16(kf[5],qr[2],C1,0,0,0),   P1[6],P1[7],P1[8],P1[9],     pw2[2]=PKW(P1,4), pw2[3]=PKW(P1,6), pw2); \
    VRD(3); SBAR(); GAPA(C0=__builtin_amdgcn_mfma_f32_32x32x16_bf16(kf[6],qr[3],C0,0,0,0),   P1[10],P1[11],P1[12],P1[13], pw3[0]=PKW(P1,8), pw3[1]=PKW(P1,10), pw3); \
    VRD(7); SBAR(); GAPA(C1=__builtin_amdgcn_mfma_f32_32x32x16_bf16(kf[7],qr[3],C1,0,0,0),   P1[14],P1[15],0.f,0.f,       pw3[2]=PKW(P1,12),pw3[3]=PKW(P1,14), pw3); \
    l_reg+=sacc; \
    if(GK){DMA_K((t)+3,sl_cur);} if(GV){DMA_V((t)+1,sl_next);} \
    CMASK(C0,C1,t); \
    { float a=MX3(C0[0],C0[1],C1[0]),b=MX3(C0[2],C0[3],C1[1]); a=MX3(a,C1[2],C1[3]); \
      _Pragma("unroll") for(int r=4;r<16;r+=4){a=MX3(a,C0[r],C0[r+1]);b=MX3(b,C0[r+2],C0[r+3]);a=MX3(a,C1[r],C1[r+1]);b=MX3(b,C1[r+2],C1[r+3]);} \
      float rm=__builtin_fmaxf(a,b); { auto rr=__builtin_amdgcn_permlane32_swap(__float_as_uint(rm),__float_as_uint(rm),false,false); rm=__builtin_fmaxf(__uint_as_float(rr[0]),__uint_as_float(rr[1])); } \
      resc=false; \
      if(__builtin_expect(__any(rm>(float)THRL),0)){ const float dl=__builtin_fmaxf(rm,0.f); mhat+=dl; \
        _Pragma("unroll") for(int r=0;r<16;++r){C0[r]-=dl;C1[r]-=dl;} \
        qoff=F2q-mhat; \
        const float f=__builtin_amdgcn_exp2f(-dl); l_reg*=f; if(hi==0)wsf[r32]=f; resc=true; } } \
    SBAR(); \
    GAPB(o[0]=__builtin_amdgcn_mfma_f32_32x32x16_bf16(PAF(0),VFR(0),o[0],0,0,0), C0,0); \
    GAPB(o[1]=__builtin_amdgcn_mfma_f32_32x32x16_bf16(PAF(0),VFR(4),o[1],0,0,0), C0,4); \
    KRD(GL,0); GAPB(o[0]=__builtin_amdgcn_mfma_f32_32x32x16_bf16(PAF(1),VFR(1),o[0],0,0,0), C0,8); \
    KRD(GL,1); GAPB(o[1]=__builtin_amdgcn_mfma_f32_32x32x16_bf16(PAF(1),VFR(5),o[1],0,0,0), C0,12); \
    KRD(GL,2); GAPB(o[0]=__builtin_amdgcn_mfma_f32_32x32x16_bf16(PAF(2),VFR(2),o[0],0,0,0), C1,0); \
    KRD(GL,3); GAPB(o[1]=__builtin_amdgcn_mfma_f32_32x32x16_bf16(PAF(2),VFR(6),o[1],0,0,0), C1,4); \
    GAPB(o[0]=__builtin_amdgcn_mfma_f32_32x32x16_bf16(PAF(3),VFR(3),o[0],0,0,0), C1,8); \
    GAPB(o[1]=__builtin_amdgcn_mfma_f32_32x32x16_bf16(PAF(3),VFR(7),o[1],0,0,0), C1,12); \
    }while(0)
  int t=1;
  #undef CMASK
  #define CMASK(P0,P1,t) do{}while(0)
  for(;t+5<NT;t+=2){
    STEP(pB0,pB1,pA0,pA1,t,true,true,true);     WAIT_BAR(2); RESC(); ROT();
    STEP(pA0,pA1,pB0,pB1,t+1,true,true,true);   WAIT_BAR(2); RESC(); ROT();
  }
  #undef CMASK
  #define CMASK(P0,P1,t) do{int jb_=(t)-(NT-4); if(jb_>=0)cmask(P0,P1,jb_,qrel,hi);}while(0)
  #define ENDW(tt) do{ if((tt)+3<NT){WAIT_BAR(2);} else if((tt)+2<NT){WAIT_BAR(1);} else {WAIT_BAR(0);} }while(0)
  for(;t+1<NT;t+=2){
    STEP(pB0,pB1,pA0,pA1,t,(t+3<NT),(t+1<NT),(t+1<NT));       ENDW(t);   RESC(); ROT();
    STEP(pA0,pA1,pB0,pB1,t+1,(t+4<NT),(t+2<NT),(t+2<NT));     ENDW(t+1); RESC(); ROT();
  }
  STEP(pB0,pB1,pA0,pA1,NT-1,false,false,false); RESC();
  { float sacc=pB0[0]+pB0[1]; _Pragma("unroll") for(int r=2;r<16;++r)sacc+=pB0[r]; _Pragma("unroll") for(int r=0;r<16;++r)sacc+=pB1[r]; l_reg+=sacc;
    pw0=(u32x4){PKW(pB0,0),PKW(pB0,2),PKW(pB0,4),PKW(pB0,6)};pw1=(u32x4){PKW(pB0,8),PKW(pB0,10),PKW(pB0,12),PKW(pB0,14)};pw2=(u32x4){PKW(pB1,0),PKW(pB1,2),PKW(pB1,4),PKW(pB1,6)};pw3=(u32x4){PKW(pB1,8),PKW(pB1,10),PKW(pB1,12),PKW(pB1,14)};
    SBAR(); pv(o,vb0+sl_cur,PAF(0),PAF(1),PAF(2),PAF(3)); }
  #undef PKW
  #undef PAF
  #undef VFR
  #undef PIN
  #undef MX3
  #undef GAPA
  #undef GAPB
  #undef EX
  #undef VRD
  #undef KRD
  #undef STEP
  #undef ENDW
  {auto rr=__builtin_amdgcn_permlane32_swap(__float_as_uint(l_reg),__float_as_uint(l_reg),false,false);l_reg=__uint_as_float(rr[0])+__uint_as_float(rr[1]);}
  if(hi==0)wsf[32+r32]=l_reg;asm volatile("s_waitcnt lgkmcnt(0)":::"memory");
  float rli[16];
  #pragma unroll
  for(int r=0;r<16;++r)rli[r]=__builtin_amdgcn_rcpf(wsf[32+crow(r,hi)]);
  bf16*Ow=O+(rowbase+q0+wid*QBLK)*OPITCH+h*D;
  { bf16*stg=(bf16*)(shm+LDS_OST)+wid*2048;
    #pragma unroll
    for(int r=0;r<16;++r){const int orow=crow(r,hi);
      #pragma unroll
      for(int d0=0;d0<2;++d0)stg[orow*64+d0*32+r32]=__float2bfloat16(o[d0][r]*rli[r]);}
    asm volatile("s_waitcnt lgkmcnt(0)":::"memory");
    #pragma unroll
    for(int i=0;i<4;++i){const int row=i*8+(lane>>3),ch=lane&7; const u32x4 v=*(const u32x4*)(stg+row*64+ch*8); ATTN_STORE16(Ow+(long)row*OPITCH+ch*8,v);} }
  asm volatile("s_waitcnt lgkmcnt(0)\n\ts_barrier":::"memory");
  #undef DMA_K
  #undef DMA_V
  #undef CMASK
  #undef START
  #undef RESC
  #undef ROT
}
constexpr int ATTN_LDS_BYTES=LDS_BYTES;
struct AttnTensors { const bf16* Q; const bf16* K; const bf16* V; const float* F2; bf16* O; };
struct AttnUnit { int bh; int qb; };
struct StaticOrder {
  int vcu;
  __device__ __forceinline__ explicit StaticOrder(int grid,int block):vcu((block%8)*(grid/8)+block/8){}
  __device__ __forceinline__ bool next(int i,AttnUnit&u)const{ if(i>=2||vcu>=256)return false; const int s=vcu&15; u.bh=vcu>>4; u.qb=(i==0)?s:31-s; return true; }
  __device__ __forceinline__ void a_ready(const AttnUnit&)const{}
  __device__ __forceinline__ void done(const AttnUnit&)const{}
};
template<class Sched,int THRL=8> __device__ __forceinline__ void attn_phase(char*lds,const AttnTensors&T,const Sched&S){
  AttnUnit u;
  for(int i=0;S.next(i,u);++i){ S.a_ready(u); attn_unit<THRL>(u.bh/NHEAD,u.bh%NHEAD,u.qb,0,T.Q,T.K,T.V,T.F2,T.O,lds); S.done(u); }
}
#undef SBAR
#undef WAIT_BAR
}
typedef float f32x4m __attribute__((ext_vector_type(4)));
__device__ __forceinline__ float bf2f(unsigned short b) { return __uint_as_float((unsigned)b << 16); }
__device__ __forceinline__ void gla_chunk_item(Frame& F, int item) {
    const int h = item & 3, c = (item >> 2) & 127, b = item >> 9, tid = F.tid, lane = F.lane, wid = F.wave;
    const size_t row0 = (size_t)b * SEQ + c * 64;
    LAS float* L = (LAS float*)(F.lds + RING_OFF); LAS float* glw = L; LAS float* la = L + 1024; LAS float* seg = L + 5120; LAS float* kd = L + 5632; LAS float* vs = L + 9728;
    const bf16* P1 = (const bf16*)(F.ws + WS_P1); const bf16* GK = P1 + (size_t)3 * M * 512 + (size_t)M * 256; const bf16* GV = P1 + (size_t)4 * M * 512;
    const float* GLOW = (const float*)(F.ws + WS_GLOW);
    const int dk = tid & 63, tq = tid >> 6;
    for (int i = tid; i < 256; i += 512) ((LAS f32x4m*)glw)[i] = ((const GAS f32x4m*)(GLOW + row0 * 16))[i];
#pragma unroll
    for (int j = 0; j < 2; ++j) { const int ch = tid + 512 * j, r = ch >> 4, c8 = (ch & 15) * 8; const v4u raw = *(const GAS v4u*)(GV + (row0 + r) * 512 + h * 128 + c8);
        LAS float* d = vs + r * 128 + c8;
        d[0] = __uint_as_float(raw.x << 16); d[1] = __uint_as_float(raw.x & 0xffff0000u); d[2] = __uint_as_float(raw.y << 16); d[3] = __uint_as_float(raw.y & 0xffff0000u);
        d[4] = __uint_as_float(raw.z << 16); d[5] = __uint_as_float(raw.z & 0xffff0000u); d[6] = __uint_as_float(raw.w << 16); d[7] = __uint_as_float(raw.w & 0xffff0000u); }
    float gu[16];
#pragma unroll
    for (int r = 0; r < 16; ++r) gu[r] = F.gup[r * 256 + h * 64 + dk];
    const float gbv = F.gbias[h * 64 + dk];
    float kv[8];
#pragma unroll
    for (int i = 0; i < 8; ++i) kv[i] = bf2f(GK[(row0 + 8 * tq + i) * 256 + h * 64 + dk]);
    __syncthreads();
    float run = 0.f;
#pragma unroll
    for (int i = 0; i < 8; ++i) { const int t = 8 * tq + i; float s = gbv;
#pragma unroll
        for (int r = 0; r < 16; ++r) s = fmaf(glw[t * 16 + r], gu[r], s);
        run += log_sigmoid_f(s) * (1.f / 16.f); la[t * 64 + dk] = run; }
    seg[tq * 64 + dk] = run;
    __syncthreads();
    float off = 0.f, total = 0.f;
#pragma unroll
    for (int q = 0; q < 8; ++q) { const float sv = seg[q * 64 + dk]; total += sv; if (q < tq) off += sv; }
#pragma unroll
    for (int i = 0; i < 8; ++i) { const int t = 8 * tq + i; kd[t * 64 + dk] = kv[i] * __expf(total - (la[t * 64 + dk] + off)); }
    if (tq == 0) ((float*)(F.ws + WS_DECAY))[((size_t)(b * 128 + c) * 4 + h) * 64 + dk] = __expf(total);
    __syncthreads();
    const int mb = wid & 3, nb0 = (wid >> 2) * 4, l15 = lane & 15, l4 = lane >> 4;
    f32x4m acc[4];
#pragma unroll
    for (int n = 0; n < 4; ++n) acc[n] = (f32x4m){0.f, 0.f, 0.f, 0.f};
#pragma unroll 4
    for (int ks = 0; ks < 16; ++ks) { const int t = 4 * ks + l4; const float a = kd[t * 64 + mb * 16 + l15];
#pragma unroll
        for (int n = 0; n < 4; ++n) acc[n] = __builtin_amdgcn_mfma_f32_16x16x4f32(a, vs[t * 128 + (nb0 + n) * 16 + l15], acc[n], 0, 0, 0); }
    float* up = (float*)(F.ws + WS_UPD) + ((size_t)(b * 128 + c) * 4 + h) * 64 * 128;
#pragma unroll
    for (int n = 0; n < 4; ++n)
#pragma unroll
        for (int r = 0; r < 4; ++r) up[(mb * 16 + 4 * l4 + r) * 128 + (nb0 + n) * 16 + l15] = acc[n][r];
    __syncthreads();
}
__device__ __forceinline__ void fscan_item(Frame& F, int bh) {
    const int b = bh >> 3, h = bh & 7, tid = F.tid, lane = F.lane, wid = F.wave;
    const float* src = (const float*)(F.ws + WS_FLT) + (size_t)h * M + (size_t)b * SEQ + 16 * tid;
    f32x4m v[4];
#pragma unroll
    for (int j = 0; j < 4; ++j) v[j] = ((const GAS f32x4m*)src)[j];
    double loc[16]; double run = 0.0;
#pragma unroll
    for (int j = 0; j < 4; ++j)
#pragma unroll
        for (int i = 0; i < 4; ++i) { run += (double)v[j][i]; loc[4 * j + i] = run; }
    double inc = run;
#pragma unroll
    for (int o = 1; o < 64; o <<= 1) { const double up = __shfl_up(inc, o); if (lane >= o) inc += up; }
    LAS double* wt = (LAS double*)(F.lds + RING_OFF);
    if (lane == 63) wt[wid] = inc;
    __syncthreads();
    double base = inc - run;
#pragma unroll
    for (int w = 0; w < 8; ++w) if (w < wid) base += wt[w];
    float* dst = (float*)(F.ws + WS_F2) + (size_t)bh * SEQ + 16 * tid;
#pragma unroll
    for (int j = 0; j < 4; ++j) { f32x4m o;
#pragma unroll
        for (int i = 0; i < 4; ++i) o[i] = (float)(base + loc[4 * j + i]);
        ((GAS f32x4m*)dst)[j] = o; }
    __syncthreads();
}
__device__ __forceinline__ void gla_scan(Frame& F, size_t dst_off = 0) {
    if (F.tid >= 256) return;
    const int nel = BATCH * GH * 64 * 128;
    for (int id = F.vcu * 256 + F.tid; id < nel; id += F.G * 256) {
        const int dv = id & 127, dkk = (id >> 7) & 63, h = (id >> 13) & 3, b = id >> 15;
        float* up = (float*)(F.ws + WS_UPD) + ((size_t)(b * 128) * 4 + h) * 64 * 128 + dkk * 128 + dv; const float* dc = (const float*)(F.ws + WS_DECAY) + ((size_t)(b * 128) * 4 + h) * 64 + dkk;
        float st = 0.f;
        for (int c0 = 0; c0 < 128; c0 += 16) { float u[16], d[16];
#pragma unroll
            for (int j = 0; j < 16; ++j) { u[j] = up[(size_t)(c0 + j) * 4 * 64 * 128]; d[j] = dc[(size_t)(c0 + j) * 4 * 64]; }
#pragma unroll
            for (int j = 0; j < 16; ++j) { st = fmaf(d[j], st, u[j]); up[dst_off + (size_t)(c0 + j) * 4 * 64 * 128] = st; } }
    }
}
__device__ __forceinline__ void gla_out_item(Frame& F, int item) {
    const int h = item & 3, c = (item >> 2) & 127, b = item >> 9, tid = F.tid, lane = F.lane, wid = F.wave;
    const size_t row0 = (size_t)b * SEQ + c * 64;
    LAS float* L = (LAS float*)(F.lds + RING_OFF); LAS float* qs = L; LAS float* st = L + 4160; LAS float* ssq = L + 12352; LAS float* ob = L + 12480;
    const bf16* P1 = (const bf16*)(F.ws + WS_P1); const bf16* GQ = P1 + (size_t)3 * M * 512; const bf16* GO = P1 + (size_t)5 * M * 512;
    const float* sp = (const float*)(F.ws + WS_UPD) + ((size_t)(b * 128 + c) * 4 + h) * 64 * 128;
#pragma unroll
    for (int j = 0; j < 4; ++j) ((LAS f32x4m*)st)[tid + 512 * j] = ((const GAS f32x4m*)sp)[tid + 512 * j];
    { const int r = tid >> 3, c8 = (tid & 7) * 8; const v4u raw = *(const GAS v4u*)(GQ + (row0 + r) * 256 + h * 64 + c8); LAS float* d = qs + r * 65 + c8;
      d[0] = __uint_as_float(raw.x << 16); d[1] = __uint_as_float(raw.x & 0xffff0000u); d[2] = __uint_as_float(raw.y << 16); d[3] = __uint_as_float(raw.y & 0xffff0000u);
      d[4] = __uint_as_float(raw.z << 16); d[5] = __uint_as_float(raw.z & 0xffff0000u); d[6] = __uint_as_float(raw.w << 16); d[7] = __uint_as_float(raw.w & 0xffff0000u); }
    __syncthreads();
    const int mb = wid & 3, nb0 = (wid >> 2) * 4, l15 = lane & 15, l4 = lane >> 4;
    f32x4m acc[4];
#pragma unroll
    for (int n = 0; n < 4; ++n) acc[n] = (f32x4m){0.f, 0.f, 0.f, 0.f};
#pragma unroll 4
    for (int ks = 0; ks < 16; ++ks) { const int kk = 4 * ks + l4; const float a = qs[(mb * 16 + l15) * 65 + kk];
#pragma unroll
        for (int n = 0; n < 4; ++n) acc[n] = __builtin_amdgcn_mfma_f32_16x16x4f32(a, st[kk * 128 + (nb0 + n) * 16 + l15], acc[n], 0, 0, 0); }
#pragma unroll
    for (int r = 0; r < 4; ++r) { float s = 0.f;
#pragma unroll
        for (int n = 0; n < 4; ++n) s += acc[n][r] * acc[n][r];
        s += __shfl_xor(s, 1); s += __shfl_xor(s, 2); s += __shfl_xor(s, 4); s += __shfl_xor(s, 8);
        if (l15 == 0) ssq[(wid >> 2) * 64 + mb * 16 + 4 * l4 + r] = s;
#pragma unroll
        for (int n = 0; n < 4; ++n) ob[(mb * 16 + 4 * l4 + r) * 132 + (nb0 + n) * 16 + l15] = acc[n][r]; }
    __syncthreads();
    { const int t = tid >> 3, d0 = (tid & 7) * 16; const float rs = 1.f / sqrtf((ssq[t] + ssq[64 + t]) * (1.f / 128.f) + EPS);
      const v4u g0 = *(const GAS v4u*)(GO + (row0 + t) * 512 + h * 128 + d0), g1 = *(const GAS v4u*)(GO + (row0 + t) * 512 + h * 128 + d0 + 8);
      const unsigned gw[8] = {g0.x, g0.y, g0.z, g0.w, g1.x, g1.y, g1.z, g1.w}; unsigned ow[8];
#pragma unroll
      for (int j = 0; j < 8; ++j) { const float ga = __uint_as_float(gw[j] << 16), gb2 = __uint_as_float(gw[j] & 0xffff0000u);
          const float oa = ob[t * 132 + d0 + 2 * j] * rs * F.gng[d0 + 2 * j] * (ga * __builtin_amdgcn_rcpf(1.f + __expf(-ga)));
          const float obv = ob[t * 132 + d0 + 2 * j + 1] * rs * F.gng[d0 + 2 * j + 1] * (gb2 * __builtin_amdgcn_rcpf(1.f + __expf(-gb2)));
          ow[j] = pk2(oa, obv); }
      bf16* dst = (bf16*)(F.ws + WS_CAT) + (row0 + t) * D + 512 + h * 128 + d0;
      *(GAS v4u*)dst = (v4u){ow[0], ow[1], ow[2], ow[3]}; *(GAS v4u*)(dst + 8) = (v4u){ow[4], ow[5], ow[6], ow[7]}; }
    __syncthreads();
}

__device__ __forceinline__ void qk_norms(Frame& F) {
    const int tid = F.tid, lane = F.lane, wid = F.wave;
    LAS unsigned* red = (LAS unsigned*)(F.lds + RING_OFF);
    const bf16* QF = (const bf16*)(F.ws + WS_P1); const bf16* KF = QF + (size_t)M * 512;
    for (int rb = F.vcu; rb < M / 64; rb += F.G) {
        const size_t off = ((size_t)rb * 64 + (tid >> 3)) * 512 + (tid & 7) * 64; float sq = 0.f, sk = 0.f;
#pragma unroll
        for (int j = 0; j < 8; ++j) { const v4u a = *(const GAS v4u*)(QF + off + 8 * j), c = *(const GAS v4u*)(KF + off + 8 * j);
            const unsigned aw[4] = {a.x, a.y, a.z, a.w}, cw[4] = {c.x, c.y, c.z, c.w};
#pragma unroll
            for (int i = 0; i < 4; ++i) { const float a0 = __uint_as_float(aw[i] << 16), a1 = __uint_as_float(aw[i] & 0xffff0000u), c0 = __uint_as_float(cw[i] << 16), c1 = __uint_as_float(cw[i] & 0xffff0000u);
                sq = fmaf(a0, a0, fmaf(a1, a1, sq)); sk = fmaf(c0, c0, fmaf(c1, c1, sk)); } }
#pragma unroll
        for (int o = 8; o < 64; o <<= 1) { sq = fmaxf(sq, __shfl_xor(sq, o)); sk = fmaxf(sk, __shfl_xor(sk, o)); }
        if (lane < 8) { red[wid * 8 + lane] = __float_as_uint(sq); red[64 + wid * 8 + lane] = __float_as_uint(sk); }
        __syncthreads();
        if (tid < 16) { const int hh = tid & 7, which = tid >> 3; unsigned m = 0u;
#pragma unroll
            for (int w = 0; w < 8; ++w) { const unsigned r = red[which * 64 + w * 8 + hh]; m = r > m ? r : m; }
            const int b = (rb * 64) / SEQ; __hip_atomic_fetch_max(F.ctl + CW_QKN + 64 * (which * 16 + b * 8 + hh), m, RLX_AGENT); }
        __syncthreads();
    }
}
constexpr float PRUNE_LOG2 = 40.f;
__device__ __forceinline__ void build_unit_table(Frame& F) {
    LAS int* cst = (LAS int*)(F.lds + RING_OFF); LAS int* t0s = cst + 512;
    const float* F2 = (const float*)(F.ws + WS_F2);
    if (F.tid >= 256) {
#pragma unroll 1
        for (int rep = 0; rep < 2; ++rep) { const int u = F.tid - 256 + 256 * rep, bh = u >> 5, qb = u & 31;
            const float qn = __uint_as_float(__hip_atomic_load(F.ctl + CW_QKN + 64 * bh, RLX_AGENT)), kn = __uint_as_float(__hip_atomic_load(F.ctl + CW_QKN + 64 * (16 + bh), RLX_AGENT));
            const float thr = -(PRUNE_LOG2 + 2.f * sqrtf(qn * kn) * 1.0001f); const float* Fr = F2 + (size_t)bh * SEQ; const float fq0 = Fr[256 * qb];
            int lo = 0, hi = 4 * qb;
            while (lo < hi) { const int mid = (lo + hi) >> 1; if (fq0 - Fr[64 * mid + 63] >= thr) hi = mid; else lo = mid + 1; }
            const int T0 = lo & ~1; cst[u] = 4 * qb + 4 - T0; t0s[u] = T0; }
    }
    __syncthreads();
    if (F.tid >= 256) {
#pragma unroll 1
        for (int rep = 0; rep < 2; ++rep) { const int u = F.tid - 256 + 256 * rep, my = cst[u]; int rank = 0;
            for (int v = 0; v < 512; ++v) { const int c = cst[v]; rank += (c > my || (c == my && v < u)) ? 1 : 0; }
            ((int*)(F.ws + WS_UTAB))[rank] = u | (t0s[u] << 16); }
    }
    __syncthreads();
}
constexpr int RW_LD = 1028;
constexpr int RT_RW = 0, RT_LOG = 32 * RW_LD * 4, RT_HIST = RT_LOG + 64 * 33 * 4, RT_BASE = RT_HIST + 128, RT_END = RT_BASE + 128;
static_assert(RT_END + 3 * 1024 <= LDSCTL_OFF, "router LDS map");
template <bool DRY = false> __device__ __forceinline__ void p6_router(Frame& F) {
    const int tid = F.tid, wid = F.wave; int lane = F.lane; asm volatile("" : "+v"(lane));
    LAS float* rwt = (LAS float*)(F.lds + RT_RW); LAS float* lg = (LAS float*)(F.lds + RT_LOG); LAS int* hist = (LAS int*)(F.lds + RT_HIST); LAS int* base = (LAS int*)(F.lds + RT_BASE);
    for (int it = 0; it < 64; ++it) { const int i = tid + 512 * it, k = i >> 5, e = i & 31; rwt[e * RW_LD + k] = F.rw[i]; }
    if (tid < 32) hist[tid] = 0;
    __syncthreads();
    const float* H = (const float*)(F.ws + WS_H); unsigned char* XN8 = F.ws + WS_XN;
    f32x4 gv[4];
#pragma unroll
    for (int j = 0; j < 4; ++j) gv[j] = ((const GAS f32x4*)F.n2g)[lane + 64 * j];
    for (int rr = 0; rr < 8; ++rr) {
        const int rl = wid * 8 + rr, m = F.vcu * 64 + rl;
        const GAS f32x4* xr = (const GAS f32x4*)(H + (size_t)m * D) + lane;
        f32x4 v[4]; float s = 0.f;
#pragma unroll
        for (int j = 0; j < 4; ++j) { v[j] = xr[64 * j]; s += (v[j].x * v[j].x + v[j].y * v[j].y) + (v[j].z * v[j].z + v[j].w * v[j].w); }
        const float rstd = 1.f / sqrtf(wave_sum(s) * (1.f / D) + EPS);
        GAS unsigned* o4 = (GAS unsigned*)(XN8 + (size_t)m * D) + lane;
#pragma unroll
        for (int j = 0; j < 4; ++j) { v[j] = v[j] * rstd * gv[j]; o4[64 * j] = pg8::pk4_fp8(v[j].x, v[j].y, v[j].z, v[j].w); }
        float a[32];
#pragma unroll
        for (int e = 0; e < 32; ++e) { float t = 0.f;
#pragma unroll
            for (int j = 0; j < 4; ++j) { const f32x4 w = *(const LAS f32x4*)(rwt + e * RW_LD + 256 * j + 4 * lane); t += (v[j].x * w.x + v[j].y * w.y) + (v[j].z * w.z + v[j].w * w.w); }
            a[e] = t; if ((e & 3) == 3) asm volatile("" ::: "memory"); }
        const float tot = bfly32(a, lane);
        if ((lane & 1) == 0) lg[rl * 33 + (lane >> 1)] = tot + F.rb[lane >> 1];
    }
    __syncthreads();
    LAS int* selL = (LAS int*)(F.lds + RT_END); LAS int* rankL = selL + 256; LAS float* gtL = (LAS float*)(rankL + 256);
    if (tid < 64) {
        float v[32];
#pragma unroll
        for (int e = 0; e < 32; ++e) v[e] = lg[tid * 33 + e];
        int sel[4] = {0, 0, 0, 0}; float sv[4];
#pragma unroll
        for (int k = 0; k < 4; ++k) { int bi = 0; float bv = -INFINITY;
#pragma unroll
            for (int e = 0; e < 32; ++e) { bool taken = false;
#pragma unroll
                for (int kk = 0; kk < 4; ++kk) if (kk < k && sel[kk] == e) taken = true;
                if (!taken && v[e] > bv) { bv = v[e]; bi = e; } }
            sel[k] = bi; sv[k] = bv; }
        float gt[4], sum = 0.f;
#pragma unroll
        for (int k = 0; k < 4; ++k) { gt[k] = __expf(sv[k] - sv[0]); sum += gt[k]; }
        const float inv = 1.f / sum;
#pragma unroll
        for (int k = 0; k < 4; ++k) { selL[tid * 4 + k] = sel[k]; gtL[tid * 4 + k] = gt[k] * inv; rankL[tid * 4 + k] = __hip_atomic_fetch_add(hist + sel[k], 1, __ATOMIC_RELAXED, __HIP_MEMORY_SCOPE_WORKGROUP); }
    }
    __syncthreads();
    if (DRY) return;
    if (tid < 32) { const int hcount = hist[tid]; base[tid] = hcount ? (int)__hip_atomic_fetch_add(F.ctl + CW_ECNT + 64 * tid, (unsigned)hcount, RLX_AGENT) : 0; }
    __syncthreads();
    if (tid < 256) { const int m = F.vcu * 64 + (tid >> 2), e = selL[tid], idx = base[e] + rankL[tid];
        unsigned char* wsb = F.ws;
        ((int*)(wsb + WS_TOKL))[(size_t)e * ECAP + idx] = m; ((int*)(wsb + WS_PIDX))[m * 4 + (tid & 3)] = idx; ((int*)(wsb + WS_EIDX))[m * 4 + (tid & 3)] = e; ((float*)(wsb + WS_GATE))[m * 4 + (tid & 3)] = gtL[tid]; }
}
constexpr int MOE_MAX_UNITS = 26;
__device__ __forceinline__ void moe_tables(Frame& F) {
    LAS int* tab = (LAS int*)(F.lds + EXTRA_OFF);
    __syncthreads();
    if (F.tid < 32) tab[128 + F.tid] = (int)__hip_atomic_load(F.ctl + CW_ECNT + 64 * F.tid, RLX_AGENT);
    __syncthreads();
    if (F.tid == 0) { int a = 0; for (int e = 0; e < 32; ++e) { tab[e] = a; tab[64 + e] = a * 256; a += (tab[128 + e] + 255) >> 8; } tab[32] = a; }
    __syncthreads();
}
template <class Sched> __device__ __forceinline__ void moe_fill_toks(Frame& F, const Sched& S) {
    LAS int* tab = (LAS int*)(F.lds + EXTRA_OFF); LAS int* toks = tab + 256; const int* TOKL = (const int*)(F.ws + WS_TOKL);
    pg8::Unit u;
    for (int i = 0; i < MOE_MAX_UNITS && S.next(i, u); ++i) if (F.tid < 256) { const int idx = (u.pm & 0xffff) * 256 + F.tid; toks[i * 256 + F.tid] = (idx < tab[128 + u.e]) ? TOKL[(size_t)u.e * ECAP + idx] : 0; }
    __syncthreads();
}
__device__ __forceinline__ void p9_combine(Frame& F) {
    int lane = F.lane; asm volatile("" : "+v"(lane)); const LAS int* tab = (const LAS int*)(F.lds + EXTRA_OFF);
    const float* H = (const float*)(F.ws + WS_H); const bf16* Y = (const bf16*)(F.ws + WS_Y);
    const int* PIDX = (const int*)(F.ws + WS_PIDX); const int* EIDX = (const int*)(F.ws + WS_EIDX); const float* GATE = (const float*)(F.ws + WS_GATE);
    f32x4 gv[4];
#pragma unroll
    for (int j = 0; j < 4; ++j) gv[j] = ((const GAS f32x4*)F.fg)[lane + 64 * j];
    const int gw = F.vcu * NWAVES + F.wave, NGW = F.G * NWAVES;
    for (int m = gw; m < M; m += NGW) {
        f32x4 v[4];
#pragma unroll
        for (int j = 0; j < 4; ++j) v[j] = ((const GAS f32x4*)(H + (size_t)m * D))[lane + 64 * j];
#pragma unroll
        for (int k = 0; k < 4; ++k) { const int e = EIDX[m * 4 + k]; const size_t slot = (size_t)tab[64 + e] + PIDX[m * 4 + k]; const float g = GATE[m * 4 + k];
            const GAS unsigned long long* yr = (const GAS unsigned long long*)(Y + slot * D) + lane;
#pragma unroll
            for (int j = 0; j < 4; ++j) { const unsigned long long w = yr[64 * j]; const unsigned lo = (unsigned)w, hi = (unsigned)(w >> 32);
                v[j].x = fmaf(g, __uint_as_float(lo << 16), v[j].x); v[j].y = fmaf(g, __uint_as_float(lo & 0xffff0000u), v[j].y);
                v[j].z = fmaf(g, __uint_as_float(hi << 16), v[j].z); v[j].w = fmaf(g, __uint_as_float(hi & 0xffff0000u), v[j].w); } }
        float s = 0.f;
#pragma unroll
        for (int j = 0; j < 4; ++j) s += (v[j].x * v[j].x + v[j].y * v[j].y) + (v[j].z * v[j].z + v[j].w * v[j].w);
        const float rstd = 1.f / sqrtf(wave_sum(s) * (1.f / D) + EPS);
#pragma unroll
        for (int j = 0; j < 4; ++j) ((GAS f32x4*)(F.out + (size_t)m * D))[lane + 64 * j] = v[j] * rstd * gv[j];
    }
}

struct Args;
typedef const __attribute__((address_space(4))) Args* KArgs;
struct Args { const float* in[16]; float* out; unsigned char* ws; int ph_lo, ph_hi; };
constexpr int N_PHASES = 10;
__global__ void __launch_bounds__(NWAVES * 64, 2) mk_fwd(Args args) {
    extern __shared__ __attribute__((aligned(16))) unsigned char lds[];
    Frame F;
    F.lds = (LAS unsigned char*)lds; F.MISC = (volatile LAS unsigned*)(F.lds + MISC_OFF);
    F.tid = threadIdx.x; F.lane = F.tid & 63; F.wave = __builtin_amdgcn_readfirstlane(F.tid >> 6);
    F.G = gridDim.x; { const int bx = blockIdx.x; F.vcu = (F.G % 8 == 0) ? (bx % 8) * (F.G / 8) + bx / 8 : bx; }
    unsigned char* ws = args.ws; F.ws = ws; F.ctl = (gu32*)(ws + WS_CTL);
    F.x = args.in[0]; F.n1g = args.in[1]; F.w_in = args.in[2]; F.fbias = args.in[3]; F.gup = args.in[4]; F.gbias = args.in[5]; F.gng = args.in[6]; F.w_out = args.in[7];
    F.n2g = args.in[8]; F.rw = args.in[9]; F.rb = args.in[10]; F.ewi = args.in[11]; F.ebi = args.in[12]; F.ewo = args.in[13]; F.ebo = args.in[14]; F.fg = args.in[15]; F.out = args.out;
    for (int u = F.tid; u < (LDS_BYTES - LDSCTL_OFF) / 4; u += NWAVES * 64) ((LAS unsigned*)(F.lds + LDSCTL_OFF))[u] = 0u;
    __syncthreads();
    const int lo = args.ph_lo, hi = args.ph_hi;
    const bool one_phase = (hi - lo) == 1;
    XcdBarrier bar; bar.bar = (unsigned*)(F.ctl + CW_BAR); bar.x = 0; bar.st = nullptr;
    if (!one_phase) bar = xcd_barrier_post((unsigned*)(F.ctl + CW_BAR), F.MISC + 8);
#define IN(k) (lo <= (k) && (k) < hi)
#define BOTH(k) (IN(k) && IN((k) + 1))
#ifndef PROBE_BAR2
#define PROBE_BAR2 0
#endif
#define GRID_BAR() do { xcd_barrier(bar); if (PROBE_BAR2) xcd_barrier(bar); } while (0)
#ifndef PROBE_DUP
#define PROBE_DUP -1
#endif
#define DUP_BEGIN(k) _Pragma("unroll") for (int rep_ = 0; rep_ < ((k) == PROBE_DUP ? 2 : 1); ++rep_) {
#define DUP_END }
#define REFRESH() do { int t_ = threadIdx.x; asm volatile("" : "+v"(t_)); F.tid = t_; F.lane = t_ & 63; \
        KArgs ap_ = (KArgs)__builtin_amdgcn_kernarg_segment_ptr(); asm volatile("" : "+s"(ap_));     \
        F.x = ap_->in[0]; F.n1g = ap_->in[1]; F.w_in = ap_->in[2]; F.fbias = ap_->in[3]; F.gup = ap_->in[4]; F.gbias = ap_->in[5]; F.gng = ap_->in[6]; F.w_out = ap_->in[7]; \
        F.n2g = ap_->in[8]; F.rw = ap_->in[9]; F.rb = ap_->in[10]; F.ewi = ap_->in[11]; F.ebi = ap_->in[12]; F.ewo = ap_->in[13]; F.ebo = ap_->in[14]; F.fg = ap_->in[15]; F.out = ap_->out; \
        ws = ap_->ws; F.ws = ws; F.ctl = (gu32*)(ws + WS_CTL); } while (0)

#ifndef SKIP_P0
    if (IN(0)) { REFRESH(); DUP_BEGIN(0) p0_prologue(F); DUP_END if (BOTH(0)) GRID_BAR(); }
#endif
#ifndef SKIP_P1
    if (IN(1)) { REFRESH(); DUP_BEGIN(1)
        pg8::Gemm g{ws + WS_XN, ws + WS_WIN, M, NPROJ, D * 2}; pg8::StaticOrder S; S.init(M, NPROJ, F.G, (int)blockIdx.x);
        pg8::EpiRoute E{(pg8::bf16_t*)(ws + WS_P1), M, C2};
        pg8::gemm_phase<pg8::EpiRoute, pg8::StaticOrder, true, true>(F.lds + RING_OFF, g, S, E);
        DUP_END if (BOTH(1)) GRID_BAR();
    }
#endif
    if (IN(2)) { REFRESH(); DUP_BEGIN(2)
        if (F.vcu < BATCH * FH) fscan_item(F, F.vcu);
        qk_norms(F);
        for (int it = F.vcu; it < BATCH * 128 * GH; it += F.G) gla_chunk_item(F, it);
        DUP_END if (BOTH(2)) GRID_BAR();
    }
    if (IN(3)) { REFRESH(); DUP_BEGIN(3) gla_scan(F, (PROBE_DUP == 3 && rep_ == 0) ? (WS_ACT - WS_UPD) / 4 : 0); DUP_END if (blockIdx.x == 0) build_unit_table(F); if (BOTH(3)) GRID_BAR(); }
#define QUEUE_A() for (;;) { \
            if (F.tid == 0) qslot[0] = (int)__hip_atomic_fetch_add(F.ctl + CW_QUEUE + (PROBE_DUP == 4 ? 128 * rep_ : 0), 1u, RLX_AGENT); \
            __syncthreads(); const int q = __builtin_amdgcn_readfirstlane(qslot[0]); __syncthreads(); \
            if (q >= 512) break; \
            const int e = __builtin_amdgcn_readfirstlane(((const int*)(ws + WS_UTAB))[q]), u = e & 0xffff, T0 = e >> 16; \
            attn_body::attn_unit<8>(u >> 8, (u >> 5) & 7, u & 31, T0, (const attn_body::bf16*)P1, (const attn_body::bf16*)(P1 + (size_t)M * 512), (const attn_body::bf16*)(P1 + (size_t)2 * M * 512), \
                                    (const float*)(ws + WS_F2), (attn_body::bf16*)(ws + WS_CAT), (char*)lds + RING_OFF); }
#define QUEUE_B() for (;;) { \
            if (F.tid == 0) qslot[0] = (int)__hip_atomic_fetch_add(F.ctl + CW_QUEUE + 64 + (PROBE_DUP == 4 ? 128 * rep_ : 0), 1u, RLX_AGENT); \
            __syncthreads(); const int p5 = __builtin_amdgcn_readfirstlane(qslot[0]); __syncthreads(); \
            if (p5 >= 5 * 512) break; \
            const int g5 = p5 / 5, r5 = p5 % 5; \
            if (r5 == 2 || r5 == 4) gla_out_item(F, 2 * g5 + (r5 >> 2)); else conv_batch(F, 3 * g5 + (r5 == 3 ? 2 : r5)); }
    if (IN(4)) { REFRESH(); DUP_BEGIN(4)
        const bf16* P1 = (const bf16*)(ws + WS_P1); LAS int* qslot = (LAS int*)(F.lds + EXTRA_OFF);
        if ((F.vcu & 7) >= 5) { QUEUE_B() }
        REFRESH(); QUEUE_A()
        REFRESH(); QUEUE_B()
        DUP_END if (BOTH(4)) GRID_BAR();
    }
#ifndef SKIP_P5
    if (IN(5)) { REFRESH(); DUP_BEGIN(5)
        pg8::Gemm g{ws + WS_CAT, ws + WS_WOUT, M, D, D * 2}; pg8::StaticOrder S; S.init(M, D, F.G, (int)blockIdx.x);
        pg8::EpiResF32 E{F.x, (float*)(ws + WS_H), D};
        pg8::gemm_phase<pg8::EpiResF32, pg8::StaticOrder, false, true>(F.lds + RING_OFF, g, S, E);
        DUP_END if (BOTH(5)) GRID_BAR();
    }
#endif
#ifndef SKIP_P6
    if (IN(6)) { REFRESH(); if (PROBE_DUP == 6) { if (F.vcu < M / 64) p6_router<true>(F); __syncthreads(); } if (F.vcu < M / 64) p6_router<false>(F); if (BOTH(6)) GRID_BAR(); }
#endif
#ifndef SKIP_P7
    if (IN(7)) { REFRESH(); DUP_BEGIN(7)
        moe_tables(F);
        pg8::Gemm g{ws + WS_XN, ws + WS_E1, M, 2048, D};
        pg8::MoeOrder<true> S; S.init((const LAS int*)(F.lds + EXTRA_OFF), (const LAS int*)(F.lds + EXTRA_OFF) + 256, 8, F.G, (int)blockIdx.x);
        moe_fill_toks(F, S);
        pg8::EpiSwiglu E{ws + WS_ACT, D, F.ebi};
        pg8::gemm_phase<pg8::EpiSwiglu, pg8::MoeOrder<true>, true, true, true>(F.lds + RING_OFF, g, S, E);
        DUP_END if (BOTH(7)) GRID_BAR();
    }
#endif
#ifndef SKIP_P8
    if (IN(8)) { REFRESH(); DUP_BEGIN(8)
        moe_tables(F);
        pg8::Gemm g{ws + WS_ACT, ws + WS_E2, M, D, D};
        pg8::MoeOrder<false> S; S.init((const LAS int*)(F.lds + EXTRA_OFF), (const LAS int*)(F.lds + EXTRA_OFF) + 256, 4, F.G, (int)blockIdx.x);
        pg8::EpiBiasBf16 E{(pg8::bf16_t*)(ws + WS_Y), D, F.ebo};
        pg8::gemm_phase<pg8::EpiBiasBf16, pg8::MoeOrder<false>, true, true, true>(F.lds + RING_OFF, g, S, E);
        DUP_END if (BOTH(8)) GRID_BAR();
    }
#endif
#ifndef SKIP_P9
    if (IN(9)) { REFRESH(); DUP_BEGIN(9) moe_tables(F); p9_combine(F); DUP_END }
#endif

#undef IN
#undef BOTH
}

static int mk_grid() {
    static int grid = 0;
    if (grid == 0) {
        int dev = 0, cus = 0;
        if (hipGetDevice(&dev) != hipSuccess || hipDeviceGetAttribute(&cus, hipDeviceAttributeMultiprocessorCount, dev) != hipSuccess) { grid = -1; return grid; }
        if (hipFuncSetAttribute((const void*)mk_fwd, hipFuncAttributeMaxDynamicSharedMemorySize, LDS_BYTES) != hipSuccess) { grid = -1; return grid; }
        int per_cu = 0;
        if (hipOccupancyMaxActiveBlocksPerMultiprocessor(&per_cu, (const void*)mk_fwd, NWAVES * 64, LDS_BYTES) != hipSuccess || per_cu < 1) { (void)hipGetLastError(); }
        grid = cus;
    }
    return grid;
}
static void mk_launch(void* const* d_in, void* d_out, void* d_ws, hipStream_t stream, int lo, int hi, int grid) {
    Args a{};
    for (int i = 0; i < 16; ++i) a.in[i] = (const float*)d_in[i];
    a.out = (float*)d_out; a.ws = (unsigned char*)d_ws; a.ph_lo = lo; a.ph_hi = hi;
    hipLaunchKernelGGL(mk_fwd, dim3(grid), dim3(NWAVES * 64), LDS_BYTES, stream, a);
}

extern "C" void kernel_launch(void* const* d_in, const int* in_sizes, int n_in, void* d_out, int out_size, void* d_ws, size_t ws_size, hipStream_t stream) {
    const int grid = mk_grid(); if (grid <= 0) return;
    if (n_in != 16 || ws_size < WS_END) return;
    (void)hipMemsetAsync((unsigned char*)d_ws + WS_CTL, 0, CTL_ZERO_BYTES, stream);
    mk_launch(d_in, d_out, d_ws, stream, 0, N_PHASES, grid);
}
```
